# Optimizing an MI355X kernel written in HIP

```python
import jax, jax.numpy as jnp
from jax import lax
import numpy as np

D_MODEL = 1024
BATCH = 32
SEQ = 2048
DEPTH = 2

N_MIXERS = 4
GROUP_W = D_MODEL // N_MIXERS
HEAD_DIM = 64
N_HEADS = GROUP_W // HEAD_DIM
NORM_EPS = 1e-6
RWKV_W_RANK = 32
RWKV_A_RANK = 32
RWKV_G_RANK = 64
RWKV_GN_EPS = 64e-5
SB_BLOCK = 128
ML_CHUNK = 64
ML_CONV = 4
GATE_CAP = 15.0
DSA_BLOCK = 128
IDX_HEADS = 4
IDX_DIM = 32
TOPK_MAX = 256
ROPE_THETA = 10000.0
N_GROUPS = 4
EXP_PER_GROUP = 8
N_EXPERTS = N_GROUPS * EXP_PER_GROUP
EXPERT_FF = D_MODEL // 2
TOP_IN_GROUP = 2
MOE_BLOCK = 128

A_SIZES = (GROUP_W, GROUP_W, GROUP_W, RWKV_W_RANK, RWKV_A_RANK, RWKV_G_RANK)
B_SIZES = (GROUP_W, GROUP_W, GROUP_W)
C_SIZES = (GROUP_W, GROUP_W, GROUP_W, GROUP_W, N_HEADS, N_HEADS)
D_SIZES = (GROUP_W, HEAD_DIM, HEAD_DIM, IDX_HEADS * IDX_DIM, IDX_DIM, IDX_HEADS)
A_COLS = sum(A_SIZES)
B_COLS = sum(B_SIZES)
C_COLS = sum(C_SIZES)
D_COLS = sum(D_SIZES)
P_TOTAL = A_COLS + B_COLS + C_COLS + D_COLS

kernel_name = "hymba_style_rwkv7_stickbreak_mlstm_dsa_hmoe"

F32 = jnp.float32


def split_cols(t, sizes):
    return jnp.split(t, [int(i) for i in np.cumsum(sizes)[:-1]], axis=-1)


def rms_norm(x, g):
    xf = x.astype(F32)
    y = xf * lax.rsqrt(jnp.mean(xf * xf, -1, keepdims=True) + NORM_EPS)
    return (y * g.astype(F32)).astype(x.dtype)


def rope(x, pos):
    half = x.shape[-1] // 2
    inv = ROPE_THETA ** (-jnp.arange(half, dtype=F32) / half)
    ang = pos.astype(F32)[:, None] * inv[None, :]
    cos = jnp.cos(ang)[None, :, None, :]
    sin = jnp.sin(ang)[None, :, None, :]
    xf = x.astype(F32)
    x1, x2 = xf[..., :half], xf[..., half:]
    return jnp.concatenate([x1 * cos - x2 * sin, x2 * cos + x1 * sin], -1).astype(x.dtype)


def token_shift(p, mu):
    prev = jnp.pad(p, ((0, 0), (1, 0), (0, 0)))[:, :-1]
    return p + (prev - p) * mu


def causal_dwconv(x, w, b):
    ch = x.shape[-1]
    y = lax.conv_general_dilated(x, w[:, None, :].astype(x.dtype), window_strides=(1,),
                                 padding=((w.shape[0] - 1, 0),),
                                 dimension_numbers=('NWC', 'WIO', 'NWC'), feature_group_count=ch)
    return y + b


def rwkv7_time_mix(p, mu, w0, w2, a0, a2, g2, k_k, k_a, r_k, ln_g, ln_b):
    B, S, _ = p.shape
    H, d = N_HEADS, HEAD_DIM
    p = token_shift(p, mu)
    r, k, v, wd, ad, gd = split_cols(p, A_SIZES)
    w = -jax.nn.softplus(-(w0 + jnp.tanh(wd) @ w2)) - 0.5
    decay = jnp.exp(-jnp.exp(w.astype(F32)))
    a = jax.nn.sigmoid(a0 + ad @ a2)
    g = jax.nn.sigmoid(gd) @ g2
    kk = (k * k_k).astype(F32).reshape(B, S, H, d)
    kk = kk / jnp.maximum(jnp.sqrt(jnp.sum(kk * kk, -1, keepdims=True)), 1e-12)
    k = k * (1 + (a - 1) * k_a)
    heads = lambda t: t.astype(F32).reshape(B, S, H, d)
    r_h, k_h, v_h, w_h, a_h = heads(r), heads(k), heads(v), heads(decay), heads(a)

    def step(state, inp):
        rt, wt, kt, vt, kkt, at = inp
        sa = jnp.einsum('bhvk,bhk->bhv', state, -kkt)
        state = (state * wt[:, :, None, :] + sa[..., None] * (kkt * at)[:, :, None, :]
                 + vt[..., None] * kt[:, :, None, :])
        return state, jnp.einsum('bhvk,bhk->bhv', state, rt)

    xs = tuple(jnp.moveaxis(t, 1, 0) for t in (r_h, w_h, k_h, v_h, kk, a_h))
    _, y = lax.scan(step, jnp.zeros((B, H, d, d), F32), xs)
    y = jnp.moveaxis(y, 0, 1)
    mean = jnp.mean(y, -1, keepdims=True)
    var = jnp.mean(jnp.square(y - mean), -1, keepdims=True)
    y = (y - mean) * lax.rsqrt(var + RWKV_GN_EPS) * ln_g.astype(F32).reshape(H, d) + ln_b.astype(F32).reshape(H, d)
    bonus = jnp.sum(r_h * k_h * r_k.astype(F32).reshape(H, d), -1, keepdims=True) * v_h
    y = (y + bonus).reshape(B, S, GROUP_W) * g.astype(F32)
    return y.astype(p.dtype)


def stick_breaking_attn(q, k, v):
    B, S, H, d = q.shape
    scale = d ** -0.5
    outs = []
    for i in range(S // SB_BLOCK):
        q0 = i * SB_BLOCK
        kl = q0 + SB_BLOCK
        z = jnp.einsum('bqhd,bkhd->bhqk', q[:, q0:kl], k[:, :kl]).astype(F32) * scale
        t_idx = q0 + jnp.arange(SB_BLOCK)[:, None]
        s_idx = jnp.arange(kl)[None, :]
        mask = s_idx < t_idx
        log1m = jnp.where(mask, jax.nn.log_sigmoid(-z), 0.0)
        cs = jnp.cumsum(log1m, -1)
        log_a = jax.nn.log_sigmoid(z) + cs[..., -1:] - cs
        att = jnp.where(mask, jnp.exp(log_a), 0.0)
        outs.append(jnp.einsum('bhqk,bkhd->bqhd', att.astype(v.dtype), v[:, :kl]))
    return jnp.concatenate(outs, 1)


def mlstm_chunkwise(q, k, v, log_i, log_f):
    B, S, H, d = q.shape
    L = ML_CHUNK
    nc = S // L

    def to_chunks(t):
        t = t.reshape((B, nc, L, H) + t.shape[3:])
        return jnp.moveaxis(jnp.moveaxis(t, 3, 2), 1, 0)

    causal = jnp.tril(jnp.ones((L, L), bool))

    def chunk(carry, inp):
        c_st, n_st, m_st = carry
        qc, kc, vc, li, lf = inp
        b = jnp.cumsum(lf, -1)
        dmat = jnp.where(causal, b[..., :, None] - b[..., None, :] + li[..., None, :], -jnp.inf)
        g_inter = b + m_st[..., None]
        m_t = jnp.maximum(g_inter, jnp.max(dmat, -1))
        s_inter = jnp.exp(g_inter - m_t)
        sqk = jnp.einsum('bhtd,bhsd->bhts', qc, kc) * jnp.exp(dmat - m_t[..., None])
        num = s_inter[..., None] * jnp.einsum('bhvd,bhtd->bhtv', c_st, qc) + jnp.einsum('bhts,bhsv->bhtv', sqk, vc)
        den = s_inter * jnp.einsum('bhd,bhtd->bht', n_st, qc) + jnp.sum(sqk, -1)
        h = num / jnp.maximum(jnp.abs(den), jnp.exp(-m_t))[..., None]
        b_last = b[..., -1]
        dec = b_last[..., None] - b + li
        m_new = jnp.maximum(b_last + m_st, jnp.max(dec, -1))
        wk = jnp.exp(dec - m_new[..., None])
        s_old = jnp.exp(b_last + m_st - m_new)
        c_st = s_old[..., None, None] * c_st + jnp.einsum('bhs,bhsv,bhsd->bhvd', wk, vc, kc)
        n_st = s_old[..., None] * n_st + jnp.einsum('bhs,bhsd->bhd', wk, kc)
        return (c_st, n_st, m_new), h

    init = (jnp.zeros((B, H, d, d), F32), jnp.zeros((B, H, d), F32), jnp.zeros((B, H), F32))
    _, hs = lax.scan(chunk, init, tuple(to_chunks(t) for t in (q, k, v, log_i, log_f)))
    hs = jnp.moveaxis(jnp.moveaxis(hs, 0, 1), 2, 3)
    return hs.reshape(B, S, H, d)


def mlstm_mix(p, conv_w, conv_b, ig_b, fg_b, norm_g):
    B, S, _ = p.shape
    H, d = N_HEADS, HEAD_DIM
    qk = jax.nn.silu(causal_dwconv(p[..., :2 * GROUP_W], conv_w, conv_b))
    q, k = qk[..., :GROUP_W], qk[..., GROUP_W:]
    _, _, v, o, ig, fg = split_cols(p, C_SIZES)
    cap = lambda t: GATE_CAP * jnp.tanh(t / GATE_CAP)
    log_i = cap((ig + ig_b).astype(F32))
    log_f = jax.nn.log_sigmoid(cap((fg + fg_b).astype(F32)))
    heads = lambda t: t.astype(F32).reshape(B, S, H, d)
    h = mlstm_chunkwise(heads(q), heads(k) * d ** -0.5, heads(v), log_i, log_f)
    h = rms_norm(h, norm_g.reshape(H, d)).reshape(B, S, GROUP_W)
    return (jax.nn.sigmoid(o.astype(F32)) * h).astype(p.dtype)


def dsa_attn(q, k, v, qi, ki, wi):
    B, S, H, d = q.shape
    n_sel = min(TOPK_MAX, S // 4)
    gather = jax.vmap(lambda t, ix: t[ix])
    outs = []
    for i in range(S // DSA_BLOCK):
        q0 = i * DSA_BLOCK
        q1 = q0 + DSA_BLOCK
        kl = min(S, max(q1, n_sel))
        adm = jnp.arange(kl)[None, :] <= (q0 + jnp.arange(DSA_BLOCK))[:, None]
        sc = jnp.einsum('bqhe,bke->bqhk', qi[:, q0:q1], ki[:, :kl]).astype(F32)
        idx_score = jnp.einsum('bqh,bqhk->bqk', wi[:, q0:q1].astype(F32), jax.nn.relu(sc))
        idx_score = jnp.where(adm, idx_score, -jnp.inf)
        vals, sel = lax.top_k(idx_score, n_sel)
        valid = jnp.isfinite(vals)
        ks = gather(k[:, :kl], sel)
        vs = gather(v[:, :kl], sel)
        logits = jnp.einsum('bqhd,bqnd->bhqn', q[:, q0:q1], ks).astype(F32) * d ** -0.5
        logits = jnp.where(valid[:, None], logits, -jnp.inf)
        prob = jax.nn.softmax(logits, -1)
        outs.append(jnp.einsum('bhqn,bqnd->bqhd', prob.astype(v.dtype), vs))
    return jnp.concatenate(outs, 1)


def hier_moe(h, wg, bg, we, be, w1, w3, w2):
    B, S, D = h.shape
    N = B * S
    hf = h.reshape(N, D)
    g_prob = jax.nn.softmax((hf @ wg).astype(F32) + bg, -1)
    g_p, g_idx = lax.top_k(g_prob, 1)
    e_logits = ((hf @ we).astype(F32) + be).reshape(N, N_GROUPS, EXP_PER_GROUP)
    e_logits = jnp.take_along_axis(e_logits, g_idx[:, :, None], axis=1)[:, 0]
    e_p, e_idx = lax.top_k(jax.nn.softmax(e_logits, -1), TOP_IN_GROUP)
    gate = g_p * e_p / jnp.sum(e_p, -1, keepdims=True)
    expert = g_idx * EXP_PER_GROUP + e_idx
    n_asg = N * TOP_IN_GROUP
    flat_e = expert.reshape(n_asg)
    flat_tok = jnp.repeat(jnp.arange(N, dtype=jnp.int32), TOP_IN_GROUP)
    flat_w = gate.reshape(n_asg)
    order = jnp.argsort(flat_e)
    se = flat_e[order]
    counts = jnp.bincount(flat_e, length=N_EXPERTS)
    start = jnp.cumsum(counts) - counts
    pad_counts = (counts + MOE_BLOCK - 1) // MOE_BLOCK * MOE_BLOCK
    pad_end = jnp.cumsum(pad_counts)
    pad_start = pad_end - pad_counts
    slot = pad_start[se] + jnp.arange(n_asg) - start[se]
    n_blocks = -(-n_asg // MOE_BLOCK) + N_EXPERTS
    n_slots = n_blocks * MOE_BLOCK
    slot_tok = jnp.full((n_slots,), N, jnp.int32).at[slot].set(flat_tok[order])
    slot_w = jnp.zeros((n_slots,), F32).at[slot].set(flat_w[order])
    blk_start = jnp.arange(n_blocks) * MOE_BLOCK
    blk_e = jnp.minimum(jnp.sum(pad_end[None, :] <= blk_start[:, None], 1), N_EXPERTS - 1)
    h_pad = jnp.concatenate([hf, jnp.zeros((1, D), hf.dtype)], 0)

    def run_block(args):
        tok, e, wt = args
        xb = h_pad[tok]
        y = (jax.nn.silu(xb @ w1[e]) * (xb @ w3[e])) @ w2[e]
        return y * wt[:, None].astype(y.dtype)

    yb = lax.map(run_block, (slot_tok.reshape(n_blocks, MOE_BLOCK), blk_e,
                             slot_w.reshape(n_blocks, MOE_BLOCK)))
    out = jnp.zeros((N + 1, D), yb.dtype).at[slot_tok].add(yb.reshape(n_slots, D))[:N]
    return out.reshape(B, S, D)


def setup_inputs(seed: int = 0) -> dict:
    key = jax.random.key(seed)
    ks = iter(jax.random.split(key, 64))
    nrm = lambda shape, s: jax.random.normal(next(ks), shape, F32) * s
    L = DEPTH
    D = D_MODEL
    return {
        "x": nrm((BATCH, SEQ, D), 1.0),
        "c": nrm((BATCH, D), 1.0),
        "ada_w": nrm((L, D, 6 * D), 0.3 * D ** -0.5),
        "ada_b": nrm((L, 6 * D), 0.02),
        "norm1_g": 1.0 + nrm((L, D), 0.1),
        "norm2_g": 1.0 + nrm((L, D), 0.1),
        "w_in": nrm((L, D, P_TOTAL), D ** -0.5),
        "rk_mu": jax.random.uniform(next(ks), (L, A_COLS), F32),
        "rk_w0": nrm((L, GROUP_W), 0.5),
        "rk_w2": nrm((L, RWKV_W_RANK, GROUP_W), 0.5 * RWKV_W_RANK ** -0.5),
        "rk_a0": nrm((L, GROUP_W), 0.5),
        "rk_a2": nrm((L, RWKV_A_RANK, GROUP_W), 0.5 * RWKV_A_RANK ** -0.5),
        "rk_g2": nrm((L, RWKV_G_RANK, GROUP_W), RWKV_G_RANK ** -0.5),
        "rk_kk": 0.85 + nrm((L, GROUP_W), 0.1),
        "rk_ka": 1.0 + nrm((L, GROUP_W), 0.1),
        "rk_rk": nrm((L, GROUP_W), 0.1),
        "rk_ln_g": 1.0 + nrm((L, GROUP_W), 0.1),
        "rk_ln_b": nrm((L, GROUP_W), 0.02),
        "sb_norm_g": 1.0 + nrm((L, GROUP_W), 0.1),
        "ml_conv_w": nrm((L, ML_CONV, 2 * GROUP_W), ML_CONV ** -0.5),
        "ml_conv_b": nrm((L, 2 * GROUP_W), 0.02),
        "ml_ig_b": -1.0 + nrm((L, N_HEADS), 0.5),
        "ml_fg_b": 3.0 + nrm((L, N_HEADS), 0.5),
        "ml_norm_g": 1.0 + nrm((L, GROUP_W), 0.1),
        "ds_qn_g": 1.0 + nrm((L, HEAD_DIM), 0.1),
        "ds_kn_g": 1.0 + nrm((L, HEAD_DIM), 0.1),
        "ds_out_g": 1.0 + nrm((L, GROUP_W), 0.1),
        "w_out": nrm((L, N_MIXERS * GROUP_W, D), (N_MIXERS * GROUP_W) ** -0.5),
        "moe_wg": nrm((L, D, N_GROUPS), D ** -0.5),
        "moe_bg": nrm((L, N_GROUPS), 0.01),
        "moe_we": nrm((L, D, N_EXPERTS), D ** -0.5),
        "moe_be": nrm((L, N_EXPERTS), 0.01),
        "moe_w1": nrm((L, N_EXPERTS, D, EXPERT_FF), D ** -0.5),
        "moe_w3": nrm((L, N_EXPERTS, D, EXPERT_FF), D ** -0.5),
        "moe_w2": nrm((L, N_EXPERTS, EXPERT_FF, D), EXPERT_FF ** -0.5),
    }


def reference(x, c, ada_w, ada_b, norm1_g, norm2_g, w_in, rk_mu, rk_w0, rk_w2, rk_a0, rk_a2, rk_g2,
              rk_kk, rk_ka, rk_rk, rk_ln_g, rk_ln_b, sb_norm_g, ml_conv_w, ml_conv_b, ml_ig_b, ml_fg_b,
              ml_norm_g, ds_qn_g, ds_kn_g, ds_out_g, w_out, moe_wg, moe_bg, moe_we, moe_be,
              moe_w1, moe_w3, moe_w2):
    B, S, _ = x.shape
    H, d = N_HEADS, HEAD_DIM
    pos = jnp.arange(S)
    c_act = jax.nn.silu(c)
    for l in range(DEPTH):
        mod = (c_act @ ada_w[l] + ada_b[l])[:, None, :]
        sh1, sc1, gt1, sh2, sc2, gt2 = jnp.split(mod, 6, axis=-1)

        h = rms_norm(x, norm1_g[l]) * (1 + sc1) + sh1
        p = h @ w_in[l]
        pA, pB, pC, pD = split_cols(p, (A_COLS, B_COLS, C_COLS, D_COLS))

        yA = rwkv7_time_mix(pA, rk_mu[l], rk_w0[l], rk_w2[l], rk_a0[l], rk_a2[l], rk_g2[l],
                            rk_kk[l], rk_ka[l], rk_rk[l], rk_ln_g[l], rk_ln_b[l])

        qb, kb, vb = (t.reshape(B, S, H, d) for t in split_cols(pB, B_SIZES))
        yB = rms_norm(stick_breaking_attn(qb, kb, vb), sb_norm_g[l].reshape(H, d)).reshape(B, S, GROUP_W)

        yC = mlstm_mix(pC, ml_conv_w[l], ml_conv_b[l], ml_ig_b[l], ml_fg_b[l], ml_norm_g[l])

        qd, kd, vd, qi, ki, wi = split_cols(pD, D_SIZES)
        qd = rope(rms_norm(qd.reshape(B, S, H, d), ds_qn_g[l]), pos)
        kd = rope(rms_norm(kd[:, :, None, :], ds_kn_g[l]), pos)[:, :, 0]
        qi = rope(qi.reshape(B, S, IDX_HEADS, IDX_DIM), pos)
        ki = rope(ki[:, :, None, :], pos)[:, :, 0]
        wi = wi * (IDX_HEADS ** -0.5 * IDX_DIM ** -0.5)
        yD = rms_norm(dsa_attn(qd, kd, vd, qi, ki, wi), ds_out_g[l].reshape(H, d)).reshape(B, S, GROUP_W)

        y = jnp.concatenate([yA, yB, yC, yD], -1) @ w_out[l]
        x = x + gt1 * y

        h = rms_norm(x, norm2_g[l]) * (1 + sc2) + sh2
        x = x + gt2 * hier_moe(h, moe_wg[l], moe_bg[l], moe_we[l], moe_be[l], moe_w1[l], moe_w3[l], moe_w2[l])
    return x
```

```cpp
#include <hip/hip_runtime.h>
#include <cstdio>
#include <cstdint>

#ifndef MK_ONE_LAUNCH
#define MK_ONE_LAUNCH 0
#endif

namespace pg8 {
#define PG8_LAS __attribute__((address_space(3)))
typedef unsigned short bf16_t;
typedef short bf16x8 __attribute__((ext_vector_type(8)));
typedef float f32x4 __attribute__((ext_vector_type(4)));
typedef unsigned u32x4 __attribute__((ext_vector_type(4)));
typedef unsigned u32x2 __attribute__((ext_vector_type(2)));
constexpr int BM = 256, BK = 64, HALF = 128, HTB = HALF * BK * 2  , STAGE_BYTES = 8 * HTB, NXCD = 8, WGM = 8;

__host__ __device__ __forceinline__ int lds_byte(int r, int c) { const int st = (r >> 4) * 2 + (c >> 5), rr = r & 15, cc = c & 31, ob = rr * 64 + cc * 2; return st * 1024 + (ob ^ (((ob >> 9) & 1) << 5)); }
__host__ __device__ __forceinline__ void stage_rc(int b, int& R, int& C) { const int st = b / 1024, sb = b % 1024, swz = sb ^ (((sb >> 9) & 1) << 5); R = (st >> 1) * 16 + swz / 64; C = (st & 1) * 32 + (swz % 64) / 2; }
__host__ __device__ __forceinline__ int perm32(int rho) { const int n = rho >> 4, i = rho & 15; return 8 * (i >> 2) + 4 * n + (i & 3); }

struct Unit { int pm, pn; const char* a; const char* b; };
struct Gemm { int K; };

__device__ __forceinline__ int xcd_remap(int wgid, int nwg) { const int q = nwg / NXCD, r = nwg % NXCD, xcd = wgid % NXCD, off = wgid / NXCD; return (xcd < r ? xcd * (q + 1) : r * (q + 1) + (xcd - r) * q) + off; }

struct DenseOrder {
    int nM, nN, nwg, G, c; const char* A; const char* Bt; size_t tstep;
    __device__ __forceinline__ void init(const void* A_, const void* Bt_, int M, int N, int K, int G_, int c_) { A = (const char*)A_; Bt = (const char*)Bt_; nM = M / BM; nN = N / BM; nwg = nM * nN; G = G_; c = c_; tstep = (size_t)BM * K * 2; }
    __device__ __forceinline__ bool next(int i, Unit& u) const {
        const long L = (long)i * G + c; if (L >= nwg) return false;
        const int wgid = xcd_remap((int)L, nwg);
        const int nig = WGM * nN, gid = wgid / nig, fm = gid * WGM, gsz = (nM - fm) < WGM ? (nM - fm) : WGM;
        u.pm = fm + ((wgid % nig) % gsz); u.pn = (wgid % nig) / gsz; u.a = A + (size_t)u.pm * tstep; u.b = Bt + (size_t)u.pn * tstep; return true;
    }
    __device__ __forceinline__ void a_ready(const Unit&) const {}
    __device__ __forceinline__ void done(const Unit&) const {}
};
struct MoeOrder {
    int ntiles, nN, nwg, G, c; const int* tile_e; const char* A; const char* W; size_t a_tile, w_exp, w_tile;
    __device__ __forceinline__ bool next(int i, Unit& u) const {
        const long L = (long)i * G + c; if (L >= nwg) return false;
        const int wgid = xcd_remap((int)L, nwg);
        const int ti = wgid / nN, pn = wgid % nN; const int e = tile_e[ti];
        u.pm = ti; u.pn = pn; u.a = A + (size_t)ti * a_tile; u.b = W + (size_t)e * w_exp + (size_t)pn * w_tile; return true;
    }
    __device__ __forceinline__ void a_ready(const Unit&) const {}
    __device__ __forceinline__ void done(const Unit&) const {}
};

__device__ __forceinline__ unsigned cvt_pk_bf16(float lo, float hi) { unsigned r; asm volatile("v_cvt_pk_bf16_f32 %0, %1, %2" : "=v"(r) : "v"(lo), "v"(hi)); return r; }

struct EpiBf16 {
    static constexpr bool PERM = true, AFTER_DRAIN = false;
    bf16_t* O; int ldc;
    __device__ __forceinline__ void operator()(const f32x4 (&acc)[2][2][4][2], const Unit& u, int wr, int wc, int fr, int fq) const {
        const int row0 = u.pm * BM + wr * 64 + fr; const int col0 = u.pn * BM + wc * 32 + 8 * fq;
#pragma unroll
        for (int ai = 0; ai < 2; ++ai)
#pragma unroll
            for (int m = 0; m < 4; ++m) { bf16_t* rowp = O + (size_t)(row0 + ai * HALF + m * 16) * ldc + col0;
#pragma unroll
                for (int bj = 0; bj < 2; ++bj) { const f32x4 v0 = acc[ai][bj][m][0], v1 = acc[ai][bj][m][1];
                    u32x4 w; w.x = cvt_pk_bf16(v0[0], v0[1]); w.y = cvt_pk_bf16(v0[2], v0[3]); w.z = cvt_pk_bf16(v1[0], v1[1]); w.w = cvt_pk_bf16(v1[2], v1[3]);
                    *(u32x4*)(rowp + bj * HALF) = w; } }
    }
};
struct EpiRes {
    static constexpr bool PERM = false, AFTER_DRAIN = false;
    const float* xres; float* out; const float* gt;
    __device__ __forceinline__ void operator()(const f32x4 (&acc)[2][2][4][2], const Unit& u, int wr, int wc, int fr, int fq) const {
        const int row0 = u.pm * BM + wr * 64 + fr; const int col0 = u.pn * BM + wc * 32 + 4 * fq; const float* g = gt + (size_t)(u.pm >> 3) * 6144 + col0;
        f32x4 gv[2][2];
#pragma unroll
        for (int bj = 0; bj < 2; ++bj)
#pragma unroll
            for (int n = 0; n < 2; ++n) gv[bj][n] = *(const f32x4*)(g + bj * HALF + n * 16);
#pragma unroll
        for (int ai = 0; ai < 2; ++ai)
#pragma unroll
            for (int m = 0; m < 4; ++m) { const size_t off = (size_t)(row0 + ai * HALF + m * 16) * 1024 + col0;
#pragma unroll
                for (int bj = 0; bj < 2; ++bj)
#pragma unroll
                    for (int n = 0; n < 2; ++n) { const f32x4 xv = *(const f32x4*)(xres + off + bj * HALF + n * 16); *(f32x4*)(out + off + bj * HALF + n * 16) = xv + gv[bj][n] * acc[ai][bj][m][n]; } }
    }
};
struct EpiSwiGLU {
    static constexpr bool PERM = true, AFTER_DRAIN = false;
    bf16_t* H;
    __device__ __forceinline__ void operator()(const f32x4 (&acc)[2][2][4][2], const Unit& u, int wr, int wc, int fr, int fq) const {
        const int row0 = u.pm * BM + wr * 64 + fr; const int hcol0 = u.pn * 128 + wc * 16 + 4 * fq;
#pragma unroll
        for (int ai = 0; ai < 2; ++ai)
#pragma unroll
            for (int m = 0; m < 4; ++m) { bf16_t* rowp = H + (size_t)(row0 + ai * HALF + m * 16) * 512 + hcol0;
#pragma unroll
                for (int bj = 0; bj < 2; ++bj) { const f32x4 a = acc[ai][bj][m][0], b = acc[ai][bj][m][1]; f32x4 o;
#pragma unroll
                    for (int i = 0; i < 4; ++i) o[i] = a[i] * __builtin_amdgcn_rcpf(1.0f + __expf(-a[i])) * b[i];
                    u32x2 w; w.x = cvt_pk_bf16(o[0], o[1]); w.y = cvt_pk_bf16(o[2], o[3]);
                    *(u32x2*)(rowp + bj * 64) = w; } }
    }
};
struct EpiGate {
    static constexpr bool PERM = true, AFTER_DRAIN = false;
    bf16_t* O; const float* rs;
    __device__ __forceinline__ void operator()(const f32x4 (&acc)[2][2][4][2], const Unit& u, int wr, int wc, int fr, int fq) const {
        const int row0 = u.pm * BM + wr * 64 + fr; const int col0 = u.pn * BM + wc * 32 + 8 * fq;
#pragma unroll
        for (int ai = 0; ai < 2; ++ai)
#pragma unroll
            for (int m = 0; m < 4; ++m) { const int row = row0 + ai * HALF + m * 16; const float s = rs[row]; bf16_t* rowp = O + (size_t)row * 1024 + col0;
#pragma unroll
                for (int bj = 0; bj < 2; ++bj) { const f32x4 v0 = acc[ai][bj][m][0] * s, v1 = acc[ai][bj][m][1] * s;
                    u32x4 w; w.x = cvt_pk_bf16(v0[0], v0[1]); w.y = cvt_pk_bf16(v0[2], v0[3]); w.z = cvt_pk_bf16(v1[0], v1[1]); w.w = cvt_pk_bf16(v1[2], v1[3]);
                    *(u32x4*)(rowp + bj * HALF) = w; } }
    }
};
template <class Epi, class Sched, bool ALIGN_EPI = false, bool SP2 = false>
__device__ __forceinline__ void gemm_phase(PG8_LAS unsigned char* lds, const Gemm g, const Sched& S, const Epi& E, const int tid) {
    const int wid = __builtin_amdgcn_readfirstlane(tid >> 6), lane = tid & 63, wr = wid >> 2, wc = wid & 3, fr = lane & 15, fq = lane >> 4;
    const int K = g.K, nt = K / BK;
    unsigned voffA[2], voffB[2];
#pragma unroll
    for (int i = 0; i < 2; ++i) { int R, C; stage_rc(tid * 16 + i * 8192, R, C); const int Rb = Epi::PERM ? ((R & ~31) + perm32(R & 31)) : R;
        voffA[i] = (unsigned)(R * K + C) * 2u; voffB[i] = (unsigned)(Rb * K + C) * 2u; }
    const size_t kstep = (size_t)(BK * 2);
    const size_t hstep = (size_t)HALF * K * 2;
    const size_t tstep = 2 * hstep;
    const unsigned ldsw = (unsigned)wid * 1024u;
    const int aoff = lds_byte(wr * 64 + fr, fq * 8), boff = lds_byte(wc * 32 + fr, fq * 8);
#define PG8_SA(b, h) (((b) * 2 + (h)) * HTB)
#define PG8_SB(b, h) ((4 + (b) * 2 + (h)) * HTB)
#define PG8_STAGE(bufoff, gbase, voff) do { _Pragma("unroll") for (int _i = 0; _i < 2; ++_i) \
        __builtin_amdgcn_global_load_lds((const unsigned*)((const char*)(gbase) + (voff)[_i]), (PG8_LAS unsigned*)(lds + (bufoff) + ldsw + _i * 8192), 16, 0, 0); } while (0)
#define PG8_LDA(dst, b, h) do { _Pragma("unroll") for (int m = 0; m < 4; ++m) _Pragma("unroll") for (int k = 0; k < 2; ++k) dst[m][k] = *(const PG8_LAS bf16x8*)(lds + PG8_SA(b, h) + aoff + m * 2048 + k * 1024); } while (0)
#define PG8_LDB(dst, b, h) do { _Pragma("unroll") for (int n = 0; n < 2; ++n) _Pragma("unroll") for (int k = 0; k < 2; ++k) dst[n][k] = *(const PG8_LAS bf16x8*)(lds + PG8_SB(b, h) + boff + n * 2048 + k * 1024); } while (0)
#define PG8_MMA(ai, bj, At, Bt) do { __builtin_amdgcn_s_setprio(1); _Pragma("unroll") for (int m = 0; m < 4; ++m) _Pragma("unroll") for (int n = 0; n < 2; ++n) _Pragma("unroll") for (int k = 0; k < 2; ++k) \
        acc[ai][bj][m][n] = __builtin_amdgcn_mfma_f32_16x16x32_bf16(Bt[n][k], At[m][k], acc[ai][bj][m][n], 0, 0, 0); __builtin_amdgcn_s_setprio(0); } while (0)
#define PG8_WAIT_V(n) asm volatile("s_waitcnt vmcnt(" #n ")" ::: "memory")
#define PG8_WAIT_L(n) asm volatile("s_waitcnt lgkmcnt(" #n ")" ::: "memory")
#define PG8_BAR __builtin_amdgcn_s_barrier()
#define PG8_SCHED __builtin_amdgcn_sched_barrier(0)
    Unit cur, nxt; int ui = 0;
    if (!S.next(0, cur)) return;
    f32x4 acc[2][2][4][2];
#pragma unroll
    for (int a = 0; a < 2; ++a)
#pragma unroll
        for (int b = 0; b < 2; ++b)
#pragma unroll
            for (int m = 0; m < 4; ++m)
#pragma unroll
                for (int n = 0; n < 2; ++n) acc[a][b][m][n] = (f32x4){0.f, 0.f, 0.f, 0.f};
    bf16x8 At[4][2], B0[2][2], B1[2][2];
    const char* cA = cur.a; const char* cB = cur.b;
    S.a_ready(cur);
    if constexpr (SP2) {
        PG8_STAGE(PG8_SB(0, 0), cB, voffB); PG8_STAGE(PG8_SB(0, 1), cB + hstep, voffB); PG8_STAGE(PG8_SA(0, 0), cA, voffA); PG8_STAGE(PG8_SA(0, 1), cA + hstep, voffA);
        if (wr == 1) PG8_BAR;
        PG8_WAIT_V(2); PG8_BAR;
        PG8_STAGE(PG8_SB(1, 0), cB + kstep, voffB); PG8_STAGE(PG8_SA(1, 0), cA + kstep, voffA); PG8_STAGE(PG8_SB(1, 1), cB + hstep + kstep, voffB);
        PG8_WAIT_V(6); PG8_BAR;
    } else {
        PG8_STAGE(PG8_SB(0, 0), cB, voffB); PG8_STAGE(PG8_SA(0, 0), cA, voffA); PG8_STAGE(PG8_SB(0, 1), cB + hstep, voffB); PG8_STAGE(PG8_SA(0, 1), cA + hstep, voffA);
        if (wr == 1) PG8_BAR;
        PG8_WAIT_V(4); PG8_BAR;
        PG8_STAGE(PG8_SB(1, 0), cB + kstep, voffB); PG8_STAGE(PG8_SA(1, 0), cA + kstep, voffA); PG8_STAGE(PG8_SB(1, 1), cB + hstep + kstep, voffB);
        PG8_WAIT_V(6); PG8_BAR;
    }
    for (;;) {
        const bool has_next = S.next(ui + 1, nxt);
        const char* nA = has_next ? nxt.a : cA; const char* nB = has_next ? nxt.b : cB;
        for (int t = 0; t < nt; t += 2) {
            const bool last = (t == nt - 2);
            const char* a1 = cA + (size_t)(t + 1) * kstep;
            const char* a2 = last ? nA : cA + (size_t)(t + 2) * kstep; const char* b2 = last ? nB : cB + (size_t)(t + 2) * kstep;
            const char* a3 = a2 + kstep; const char* b3 = b2 + kstep;
            if (last && has_next) S.a_ready(nxt);
            if constexpr (SP2) {
            PG8_LDB(B0, 0, 0); PG8_LDB(B1, 0, 1); PG8_SCHED; PG8_LDA(At, 0, 0); PG8_STAGE(PG8_SA(1, 1), a1 + hstep, voffA);
            PG8_WAIT_V(8); PG8_WAIT_L(0); PG8_BAR; PG8_MMA(0, 0, At, B0); PG8_MMA(0, 1, At, B1); PG8_BAR; PG8_SCHED;
            PG8_LDA(At, 0, 1); PG8_STAGE(PG8_SB(0, 0), b2, voffB); PG8_STAGE(PG8_SB(0, 1), b2 + hstep, voffB); PG8_STAGE(PG8_SA(0, 0), a2, voffA);
            PG8_WAIT_V(8); PG8_WAIT_L(0); PG8_BAR; PG8_MMA(1, 0, At, B0); PG8_MMA(1, 1, At, B1); PG8_BAR; PG8_SCHED;
            PG8_LDB(B0, 1, 0); PG8_LDB(B1, 1, 1); PG8_SCHED; PG8_LDA(At, 1, 0); PG8_STAGE(PG8_SA(0, 1), a2 + hstep, voffA);
            PG8_WAIT_V(8); PG8_WAIT_L(0); PG8_BAR; PG8_MMA(0, 0, At, B0); PG8_MMA(0, 1, At, B1); PG8_BAR; PG8_SCHED;
            PG8_LDA(At, 1, 1); PG8_STAGE(PG8_SB(1, 0), b3, voffB); PG8_STAGE(PG8_SB(1, 1), b3 + hstep, voffB); PG8_STAGE(PG8_SA(1, 0), a3, voffA);
            PG8_WAIT_V(8); PG8_WAIT_L(0); PG8_BAR; PG8_MMA(1, 0, At, B0); PG8_MMA(1, 1, At, B1); PG8_BAR; PG8_SCHED;
            } else {
            PG8_LDB(B0, 0, 0); PG8_SCHED; PG8_LDA(At, 0, 0); PG8_STAGE(PG8_SA(1, 1), a1 + hstep, voffA);
            PG8_WAIT_L(8); PG8_BAR; PG8_WAIT_L(0); PG8_MMA(0, 0, At, B0); PG8_BAR; PG8_SCHED;
            PG8_LDB(B1, 0, 1); PG8_STAGE(PG8_SB(0, 0), b2, voffB);
            PG8_BAR; PG8_WAIT_L(0); PG8_MMA(0, 1, At, B1); PG8_BAR;
            PG8_LDA(At, 0, 1); PG8_STAGE(PG8_SA(0, 0), a2, voffA);
            PG8_BAR; PG8_WAIT_L(0); PG8_MMA(1, 0, At, B0); PG8_BAR; PG8_SCHED;
            PG8_STAGE(PG8_SB(0, 1), b2 + hstep, voffB);
            PG8_WAIT_V(6); PG8_BAR; PG8_MMA(1, 1, At, B1); PG8_BAR;
            PG8_LDB(B0, 1, 0); PG8_SCHED; PG8_LDA(At, 1, 0); PG8_STAGE(PG8_SA(0, 1), a2 + hstep, voffA);
            PG8_WAIT_L(8); PG8_BAR; PG8_WAIT_L(0); PG8_MMA(0, 0, At, B0); PG8_BAR; PG8_SCHED;
            PG8_LDB(B1, 1, 1); PG8_STAGE(PG8_SB(1, 0), b3, voffB);
            PG8_BAR; PG8_WAIT_L(0); PG8_MMA(0, 1, At, B1); PG8_BAR;
            PG8_LDA(At, 1, 1); PG8_STAGE(PG8_SA(1, 0), a3, voffA);
            PG8_BAR; PG8_WAIT_L(0); PG8_MMA(1, 0, At, B0); PG8_BAR; PG8_SCHED;
            PG8_STAGE(PG8_SB(1, 1), b3 + hstep, voffB);
            PG8_WAIT_V(6); PG8_BAR; PG8_MMA(1, 1, At, B1); PG8_BAR;
            }
        }
        if constexpr (ALIGN_EPI) { if (wr == 0) PG8_BAR; }
        if constexpr (!Epi::AFTER_DRAIN) { E(acc, cur, wr, wc, fr, fq); S.done(cur); }
        if (!has_next) break;
#pragma unroll
        for (int a = 0; a < 2; ++a)
#pragma unroll
            for (int b = 0; b < 2; ++b)
#pragma unroll
                for (int m = 0; m < 4; ++m)
#pragma unroll
                    for (int n = 0; n < 2; ++n) acc[a][b][m][n] = (f32x4){0.f, 0.f, 0.f, 0.f};
        cur = nxt; cA = nA; cB = nB; ++ui;
        if constexpr (ALIGN_EPI) { if (wr == 1) PG8_BAR; }
    }
    PG8_WAIT_V(0);
    if constexpr (!ALIGN_EPI) { if (wr == 0) PG8_BAR; }
    PG8_BAR;
    if constexpr (Epi::AFTER_DRAIN) { E.fused(acc, cur, wr, wc, fr, fq, lds, wid, lane); S.done(cur); }
#undef PG8_SA
#undef PG8_SB
#undef PG8_STAGE
#undef PG8_LDA
#undef PG8_LDB
#undef PG8_MMA
#undef PG8_WAIT_V
#undef PG8_WAIT_L
#undef PG8_BAR
#undef PG8_SCHED
}
}

#ifndef PH_MASK
#define PH_MASK 0x7fff
#endif
#define PHE(b) ((PH_MASK >> (b)) & 1)
constexpr int DM = 1024, NB = 32, SEQ = 2048, NTOK = NB * SEQ, DEPTH = 2, NWAVES = 8;
constexpr int PW = 3328;
constexpr int PREF = 3244;
constexpr int A_R = 0, A_K = 256, A_V = 512, A_WD = 768, A_AD = 800, A_GD = 832;
constexpr int B_Q = 896, B_K = 1152, B_V = 1408;
constexpr int C_Q = 1664, C_K = 1920, C_V = 2176, C_O = 2432, C_I = 2688, C_F = 2692;
constexpr int D_Q = 2752, D_K = 3008, D_V = 3072, D_QI = 3136, D_KI = 3264, D_WI = 3296;
constexpr int DREF0 = 2696;
constexpr int NEXP = 32, FF = 512;
constexpr int MAXSLOT = NTOK * 2 + NEXP * 256;
constexpr int MAXTILES = MAXSLOT / 256;

constexpr size_t MiB = 1u << 20;
constexpr size_t WS_CTL = 0, CTL_ZERO_BYTES = 1 * MiB;
constexpr size_t WS_MOD = 1 * MiB;
constexpr size_t WS_ROPE = 3 * MiB;
constexpr size_t WS_WIN = 4 * MiB;
constexpr size_t WS_WOUT = 17 * MiB;
constexpr size_t WS_WR = 21 * MiB;
constexpr size_t WS_W13 = 22 * MiB;
constexpr size_t WS_W2 = 150 * MiB;
constexpr size_t WS_ROUTE = 214 * MiB;
constexpr size_t RT_EXPERT = 0, RT_GATE = 512 * 1024, RT_TOKSLOT = 1024 * 1024, RT_SLOTW = 1536 * 1024, RT_CNT = 2304 * 1024, RT_TILE = 2368 * 1024;
constexpr size_t WS_MASK = 218 * MiB;
constexpr size_t WS_XN = 234 * MiB;
constexpr size_t WS_YCAT = 362 * MiB;
constexpr size_t WS_P = 490 * MiB;
constexpr size_t WS_XS = WS_P;
constexpr size_t WS_H = WS_P + 272 * MiB;
constexpr size_t WS_END = 906 * MiB;
static_assert(WS_H + (size_t)MAXSLOT * 512 * 2 <= WS_END && WS_P + (size_t)NTOK * PW * 2 <= WS_END, "ws map");
constexpr int CW_Q = 64;
constexpr int CW_BAR = 4096;

constexpr int LDS_BYTES = 155648;
constexpr int MISC_OFF = 153600;

#define GAS __attribute__((address_space(1)))
#define LAS __attribute__((address_space(3)))
typedef unsigned short bf16;
typedef unsigned v4u __attribute__((ext_vector_type(4)));
typedef float f32x4 __attribute__((ext_vector_type(4)));
typedef short bf16x8 __attribute__((ext_vector_type(8)));
typedef GAS unsigned gu32;
typedef GAS unsigned long long gu64;
#define RLX_AGENT __ATOMIC_RELAXED, __HIP_MEMORY_SCOPE_AGENT
#define LDS_WAIT() asm volatile("s_waitcnt lgkmcnt(0)" ::: "memory")
#define VM_WAIT() asm volatile("s_waitcnt vmcnt(0)" ::: "memory")
__device__ __forceinline__ unsigned long long rt() { return __builtin_amdgcn_s_memrealtime(); }
__device__ __forceinline__ unsigned f2bf(float f) { unsigned u = __builtin_bit_cast(unsigned, f); return (u + 0x7fffu + ((u >> 16) & 1u)) >> 16; }
__device__ __forceinline__ unsigned pk2(float lo, float hi) { return f2bf(lo) | (f2bf(hi) << 16); }

#define XB_TMO      128
#define XB_XCNT(j)  (256  + 64 * (j))
#define XB_XSUB(j)  (1280 + 64 * (j))
#define XB_XGEN(j)  (2304 + 64 * (j))
#define XB_TOP      3328
#define XB_TOPGEN   3392
#define XCD_BAR_WORDS 3456
#define XB_SPIN_CAP (1u << 18)

__device__ __forceinline__ unsigned xb_ld(unsigned* p)              { return __hip_atomic_load(p, __ATOMIC_RELAXED, __HIP_MEMORY_SCOPE_AGENT); }
__device__ __forceinline__ unsigned xb_add(unsigned* p, unsigned v) { return __hip_atomic_fetch_add(p, v, __ATOMIC_RELAXED, __HIP_MEMORY_SCOPE_AGENT); }
__device__ __forceinline__ unsigned xb_xcc_id() { return (unsigned)__builtin_amdgcn_s_getreg((3 << 11) | 20) & 0xFu; }
#define XB_SPIN(cond, bar) do { unsigned _sp = 0; while (cond) { __builtin_amdgcn_s_sleep(1); \
    if ((++_sp & 255u) == 0u) { if (xb_ld(&(bar)[XB_TMO])) break; if (_sp > XB_SPIN_CAP) { atomicAdd(&(bar)[XB_TMO], 1u); break; } } } } while (0)

struct XcdBarrier {
    unsigned* bar; unsigned x;
    volatile LAS unsigned* st;
};

__device__ __forceinline__ XcdBarrier xcd_barrier_post(unsigned* bar, volatile LAS unsigned* st) {
    XcdBarrier b; b.bar = bar; b.x = xb_xcc_id(); b.st = st;
    if (threadIdx.x == 0) (void)xb_add(&bar[XB_XCNT(b.x)], 1u);
    return b;
}
__device__ __forceinline__ void xcd_barrier_complete(unsigned* bar, unsigned x, unsigned& nloc, unsigned& nx) {
    const unsigned G = gridDim.x * gridDim.y * gridDim.z;
    unsigned sum, cnt, mine, sp = 0u;
    for (;;) {
        sum = 0u; cnt = 0u; mine = 0u;
#pragma unroll
        for (unsigned j = 0; j < 16; ++j) { const unsigned c = xb_ld(&bar[XB_XCNT(j)]); sum += c; cnt += (c > 0u) ? 1u : 0u; mine = (j == x) ? c : mine; }
        if (sum == G) break;
        __builtin_amdgcn_s_sleep(1);
        if ((++sp & 255u) == 0u) { if (xb_ld(&bar[XB_TMO])) break; if (sp > XB_SPIN_CAP) { atomicAdd(&bar[XB_TMO], 1u); break; } }
    }
    nloc = mine > 0u ? mine : 1u; nx = cnt > 0u ? cnt : 1u;
}

__device__ __forceinline__ void xcd_barrier(const XcdBarrier& b) {
    asm volatile("s_waitcnt vmcnt(0)" ::: "memory");
    __syncthreads();
    if (threadIdx.x == 0) {
        unsigned* bar = b.bar;
        __builtin_amdgcn_s_waitcnt(0);
        unsigned nloc = b.st[0], nx = b.st[1];
        if (nloc == 0u) { xcd_barrier_complete(bar, b.x, nloc, nx); b.st[0] = nloc; b.st[1] = nx; }
        const unsigned old = xb_add(&bar[XB_XSUB(b.x)], 1u);
        const unsigned gen = old / nloc;
        if (old + 1u == (gen + 1u) * nloc) {
            __builtin_amdgcn_fence(__ATOMIC_RELEASE, "agent");
            asm volatile("s_waitcnt vmcnt(0)" ::: "memory");
            const unsigned og = xb_add(&bar[XB_TOP], 1u);
            const unsigned tg = og / nx;
            if (og + 1u == (tg + 1u) * nx) xb_add(&bar[XB_TOPGEN], 1u);
            else XB_SPIN(xb_ld(&bar[XB_TOPGEN]) == tg, bar);
            __builtin_amdgcn_fence(__ATOMIC_ACQUIRE, "agent");
            xb_add(&bar[XB_XGEN(b.x)], 1u);
            asm volatile("s_waitcnt vmcnt(0)" ::: "memory");
        } else {
            XB_SPIN(xb_ld(&bar[XB_XGEN(b.x)]) == gen, bar);
            __builtin_amdgcn_fence(__ATOMIC_ACQUIRE, "agent");
            asm volatile("s_waitcnt vmcnt(0)" ::: "memory");
        }
    }
    __syncthreads();
}

struct Args { const float* in[35]; float* out; unsigned char* ws; int ph_lo, ph_hi; };
typedef float f32x16 __attribute__((ext_vector_type(16)));
typedef unsigned u32x2v __attribute__((ext_vector_type(2)));
struct Frame {
    unsigned char* lds;
    gu32* ctl;
    int tid, lane, wave, vcu, G, bid;
    const Args* A;
    float* out; unsigned char* ws;
};
enum { I_X = 0, I_C, I_ADAW, I_ADAB, I_N1G, I_N2G, I_WIN, I_MU, I_W0, I_W2, I_A0, I_A2, I_G2, I_KK, I_KA, I_RK, I_LNG, I_LNB, I_SBG, I_CONVW, I_CONVB, I_IGB, I_FGB, I_MLG,
       I_QNG, I_KNG, I_DOG, I_WOUT, I_WG, I_BG, I_WE, I_BE, I_MW1, I_MW3, I_MW2 };

__device__ __forceinline__ float bf2f(unsigned short u) { return __uint_as_float(((unsigned)u) << 16); }
__device__ __forceinline__ float bflo(unsigned u) { return __uint_as_float(u << 16); }
__device__ __forceinline__ float bfhi(unsigned u) { return __uint_as_float(u & 0xffff0000u); }
__device__ __forceinline__ float sigmoidf_(float x) { return __builtin_amdgcn_rcpf(1.0f + __expf(-x)); }
__device__ __forceinline__ float softplusf_(float x) { return fmaxf(x, 0.f) + __logf(1.0f + __expf(-fabsf(x))); }
__device__ __forceinline__ float wave_sum(float v) {
#pragma unroll
    for (int o = 1; o < 64; o <<= 1) v += __shfl_xor(v, o);
    return v;
}
__device__ __forceinline__ float sum16(float v) { v += __shfl_xor(v, 1); v += __shfl_xor(v, 2); v += __shfl_xor(v, 4); v += __shfl_xor(v, 8); return v; }
__device__ __forceinline__ float sum8(float v) { v += __shfl_xor(v, 1); v += __shfl_xor(v, 2); v += __shfl_xor(v, 4); return v; }

__device__ __forceinline__ int rowmap(int mode, int n) {
    if (mode == 1) return n < DREF0 ? n : n + (D_Q - DREF0);
    if (mode == 2) return 8 * (n >> 2) + (n & 3);
    if (mode == 3) return 8 * (n >> 2) + 4 + (n & 3);
    return n;
}
__device__ __forceinline__ void tr_item(const float* W, int K, int N, bf16* WT, int mode, float* scr, int kb, int nb, int lane) {
    const int k0 = 64 * kb, n0 = 32 * nb;
    const int nn = n0 + (lane & 31);
#pragma unroll 8
    for (int i = 0; i < 32; ++i) { const int kk = 2 * i + (lane >> 5); scr[kk * 33 + (lane & 31)] = (nn < N) ? W[(size_t)(k0 + kk) * N + nn] : 0.f; }
    LDS_WAIT(); asm volatile("" ::: "memory");
    const int c = lane & 7;
#pragma unroll
    for (int j = 0; j < 4; ++j) { const int nl = (lane >> 3) + 8 * j; const int n = n0 + nl; const float* s = scr + (8 * c) * 33 + nl;
        v4u o; o.x = pk2(s[0 * 33], s[1 * 33]); o.y = pk2(s[2 * 33], s[3 * 33]); o.z = pk2(s[4 * 33], s[5 * 33]); o.w = pk2(s[6 * 33], s[7 * 33]);
        if (n < N) *(v4u*)(WT + (size_t)rowmap(mode, n) * K + k0 + 8 * c) = o; }
    LDS_WAIT(); asm volatile("" ::: "memory");
}
__device__ __forceinline__ void p0_prologue(Frame& F) {
    unsigned char* ws = F.ws;
    if (F.bid < 192) {
        float* ca = (float*)F.lds;
        const float* c = F.A->in[I_C];
        for (int idx = F.tid; idx < 32768; idx += 512) { const int b = idx & 31, k = idx >> 5; const float cv = c[b * 1024 + k]; ca[idx] = cv * sigmoidf_(cv); }
        __syncthreads();
        const int l = F.bid / 96, cb = F.bid % 96; const int col = cb * 64 + (F.tid & 63), bg = F.tid >> 6;
        const float* W = F.A->in[I_ADAW] + (size_t)l * 1024 * 6144 + col;
        f32x4 acc = {0.f, 0.f, 0.f, 0.f};
#pragma unroll 8
        for (int k = 0; k < 1024; ++k) { const float w = W[(size_t)k * 6144]; const f32x4 cv = *(const f32x4*)(ca + k * 32 + 4 * bg); acc += w * cv; }
        const float bb = F.A->in[I_ADAB][l * 6144 + col];
        float* MOD = (float*)(ws + WS_MOD) + (size_t)l * 32 * 6144;
#pragma unroll
        for (int i = 0; i < 4; ++i) MOD[(size_t)(4 * bg + i) * 6144 + col] = acc[i] + bb;
        __syncthreads();
    }
    const int gt = F.bid * 512 + F.tid, NGT = F.G * 512;
    { float* rope = (float*)(ws + WS_ROPE);
      for (int idx = gt; idx < 2048 * 32; idx += NGT) { const int pos = idx >> 5, i = idx & 31; const float inv = powf(10000.0f, -(float)i / 32.0f); const float ang = (float)pos * inv; float s, c; sincosf(ang, &s, &c); rope[2 * idx] = c; rope[2 * idx + 1] = s; } }
    { bf16* wr = (bf16*)(ws + WS_WR);
      for (int idx = gt; idx < 2 * 36 * 1024; idx += NGT) { const int l = idx / (36 * 1024), r = idx % (36 * 1024), o = r >> 10, k = r & 1023;
          const float v = (o < 4) ? F.A->in[I_WG][((size_t)l * 1024 + k) * 4 + o] : F.A->in[I_WE][((size_t)l * 1024 + k) * 32 + (o - 4)]; wr[idx] = (bf16)f2bf(v); } }
    { bf16* win = (bf16*)(ws + WS_WIN);
      for (int idx = gt; idx < 2 * 84 * 128; idx += NGT) { const int l = idx / (84 * 128), r = idx % (84 * 128), rr = r >> 7, ch = r & 127; const int row = rr < 56 ? DREF0 + rr : 3300 + (rr - 56);
          *(v4u*)(win + ((size_t)l * PW + row) * 1024 + ch * 8) = (v4u){0u, 0u, 0u, 0u}; } }
    float* scr = (float*)(F.lds + F.wave * 16384);
    const int gw = F.vcu * NWAVES + F.wave, NGW = F.G * NWAVES;
    constexpr int I_IN = 16 * 102, I_OUT = 16 * 32, I_E = 256;
    constexpr int N_IN = 2 * I_IN, N_OUT = 2 * I_OUT, N_E = 64 * I_E;
    constexpr int NITEMS = N_IN + N_OUT + 3 * N_E;
    for (int it = gw; it < NITEMS; it += NGW) {
        int r = it;
        if (r < N_IN) { const int l = r / I_IN, q = r % I_IN; tr_item(F.A->in[I_WIN] + (size_t)l * 1024 * PREF, 1024, PREF, (bf16*)(ws + WS_WIN) + (size_t)l * PW * 1024, 1, scr, q / 102, q % 102, F.lane); continue; } r -= N_IN;
        if (r < N_OUT) { const int l = r / I_OUT, q = r % I_OUT; tr_item(F.A->in[I_WOUT] + (size_t)l * 1024 * 1024, 1024, 1024, (bf16*)(ws + WS_WOUT) + (size_t)l * 1024 * 1024, 0, scr, q / 32, q % 32, F.lane); continue; } r -= N_OUT;
        if (r < N_E) { const int le = r / I_E, q = r % I_E; tr_item(F.A->in[I_MW1] + (size_t)le * 1024 * 512, 1024, 512, (bf16*)(ws + WS_W13) + (size_t)le * 1024 * 1024, 2, scr, q / 16, q % 16, F.lane); continue; } r -= N_E;
        if (r < N_E) { const int le = r / I_E, q = r % I_E; tr_item(F.A->in[I_MW3] + (size_t)le * 1024 * 512, 1024, 512, (bf16*)(ws + WS_W13) + (size_t)le * 1024 * 1024, 3, scr, q / 16, q % 16, F.lane); continue; } r -= N_E;
        { const int le = r / I_E, q = r % I_E; tr_item(F.A->in[I_MW2] + (size_t)le * 512 * 1024, 512, 1024, (bf16*)(ws + WS_W2) + (size_t)le * 1024 * 512, 0, scr, q / 32, q % 32, F.lane); }
    }
}

__device__ __forceinline__ void norm_rows(Frame& F, const float* xsrc, int l, int which  ) {
    const int gw = F.bid * NWAVES + F.wave; const int m0 = gw * 32, b = m0 >> 11;
    const float* g = (which ? F.A->in[I_N2G] : F.A->in[I_N1G]) + l * 1024;
    const float* MOD = (const float*)(F.ws + WS_MOD) + ((size_t)l * 32 + b) * 6144 + which * 3072;
    f32x4 mul[4], add[4];
#pragma unroll
    for (int j = 0; j < 4; ++j) { const int e = 4 * (F.lane + 64 * j); const f32x4 gv = *(const f32x4*)(g + e), sc = *(const f32x4*)(MOD + 1024 + e); mul[j] = gv * (1.0f + sc); add[j] = *(const f32x4*)(MOD + e); }
    bf16* XN = (bf16*)(F.ws + WS_XN);
    for (int r = 0; r < 32; ++r) {
        const size_t m = (size_t)(m0 + r);
        const f32x4* xr = (const f32x4*)(xsrc + m * 1024) + F.lane;
        f32x4 v[4]; float s = 0.f;
#pragma unroll
        for (int j = 0; j < 4; ++j) { v[j] = xr[64 * j]; s += (v[j].x * v[j].x + v[j].y * v[j].y) + (v[j].z * v[j].z + v[j].w * v[j].w); }
        const float rs = rsqrtf(wave_sum(s) * (1.0f / 1024.0f) + 1e-6f);
        unsigned long long* o8 = (unsigned long long*)(XN + m * 1024) + F.lane;
#pragma unroll
        for (int j = 0; j < 4; ++j) { const f32x4 h = v[j] * rs * mul[j] + add[j]; o8[64 * j] = (unsigned long long)pk2(h.x, h.y) | ((unsigned long long)pk2(h.z, h.w) << 32); }
    }
}

__device__ __forceinline__ void norm2_route(Frame& F, int l) {
    unsigned char* ws = F.ws;
    unsigned* wrl = (unsigned*)F.lds;
    int* hist = (int*)(F.lds + 73728);
    { const v4u* src = (const v4u*)((const bf16*)(ws + WS_WR) + (size_t)l * 36 * 1024); v4u* dst = (v4u*)F.lds;
      for (int i = F.tid; i < 36 * 1024 * 2 / 16; i += 512) dst[i] = src[i];
      if (F.tid < 32) hist[F.tid] = 0; }
    __syncthreads();
    const int gw = F.bid * NWAVES + F.wave; const int m0 = gw * 32, b = m0 >> 11;
    const float* g = F.A->in[I_N2G] + l * 1024;
    const float* MOD = (const float*)(ws + WS_MOD) + ((size_t)l * 32 + b) * 6144 + 3072;
    f32x4 mul[4], add[4];
#pragma unroll
    for (int j = 0; j < 4; ++j) { const int e = 4 * (F.lane + 64 * j); const f32x4 gv = *(const f32x4*)(g + e), sc = *(const f32x4*)(MOD + 1024 + e); mul[j] = gv * (1.0f + sc); add[j] = *(const f32x4*)(MOD + e); }
    bf16* XN = (bf16*)(ws + WS_XN);
    int* EXPERT = (int*)(ws + WS_ROUTE + RT_EXPERT); float* GATE = (float*)(ws + WS_ROUTE + RT_GATE);
    const float* bgp = F.A->in[I_BG] + l * 4; const float* bep = F.A->in[I_BE] + l * 32;
    const float* xsrc = F.out;
    for (int r = 0; r < 32; ++r) {
        const size_t m = (size_t)(m0 + r);
        const f32x4* xr = (const f32x4*)(xsrc + m * 1024) + F.lane;
        f32x4 v[4]; float s = 0.f;
#pragma unroll
        for (int j = 0; j < 4; ++j) { v[j] = xr[64 * j]; s += (v[j].x * v[j].x + v[j].y * v[j].y) + (v[j].z * v[j].z + v[j].w * v[j].w); }
        const float rs = rsqrtf(wave_sum(s) * (1.0f / 1024.0f) + 1e-6f);
        unsigned long long* o8 = (unsigned long long*)(XN + m * 1024) + F.lane;
#pragma unroll
        for (int j = 0; j < 4; ++j) { v[j] = v[j] * rs * mul[j] + add[j]; o8[64 * j] = (unsigned long long)pk2(v[j].x, v[j].y) | ((unsigned long long)pk2(v[j].z, v[j].w) << 32); }
        float lg[36];
#pragma unroll
        for (int o = 0; o < 36; ++o) { float a = 0.f;
#pragma unroll
            for (int j = 0; j < 4; ++j) { const u32x2v w = *(const u32x2v*)(wrl + o * 512 + 2 * (F.lane + 64 * j)); a += v[j].x * bflo(w.x) + v[j].y * bfhi(w.x) + v[j].z * bflo(w.y) + v[j].w * bfhi(w.y); }
            lg[o] = wave_sum(a); }
        float gl[4]; int gi = 0;
#pragma unroll
        for (int i = 0; i < 4; ++i) gl[i] = lg[i] + bgp[i];
        float gmax = gl[0];
#pragma unroll
        for (int i = 1; i < 4; ++i) if (gl[i] > gmax) { gmax = gl[i]; gi = i; }
        float gsum = 0.f;
#pragma unroll
        for (int i = 0; i < 4; ++i) gsum += __expf(gl[i] - gmax);
        const float gp = 1.0f / gsum;
        float el[8];
#pragma unroll
        for (int i = 0; i < 8; ++i) { float x0 = lg[4 + i] + bep[i], x1 = lg[12 + i] + bep[8 + i], x2 = lg[20 + i] + bep[16 + i], x3 = lg[28 + i] + bep[24 + i]; el[i] = gi == 0 ? x0 : gi == 1 ? x1 : gi == 2 ? x2 : x3; }
        int e1 = 0; float l1 = el[0];
#pragma unroll
        for (int i = 1; i < 8; ++i) if (el[i] > l1) { l1 = el[i]; e1 = i; }
        int e2 = -1; float l2 = -INFINITY;
#pragma unroll
        for (int i = 0; i < 8; ++i) if (i != e1 && el[i] > l2) { l2 = el[i]; e2 = i; }
        const float t2 = __expf(l2 - l1); const float w1 = gp / (1.0f + t2), w2 = gp * t2 / (1.0f + t2);
        if (F.lane == 0) { EXPERT[2 * m] = gi * 8 + e1; EXPERT[2 * m + 1] = gi * 8 + e2; GATE[2 * m] = w1; GATE[2 * m + 1] = w2; atomicAdd(&hist[gi * 8 + e1], 1); atomicAdd(&hist[gi * 8 + e2], 1); }
    }
    __syncthreads();
    if (F.tid < 32) ((int*)(ws + WS_ROUTE + RT_CNT))[F.bid * 32 + F.tid] = hist[F.tid];
    __syncthreads();
}

__device__ __forceinline__ void slot_gather(Frame& F) {
    unsigned char* ws = F.ws;
    int* L = (int*)F.lds; int* partAll = L, *partBef = L + 512, *tot = L + 1024, *bef = L + 1056, *base = L + 1088, *cursor = L + 1120, *slotL = L + 1152;
    const int* CNT = (const int*)(ws + WS_ROUTE + RT_CNT);
    { const int e = F.tid & 31, part = F.tid >> 5; int sa = 0, sb = 0;
      for (int w = part * 16; w < part * 16 + 16; ++w) { const int c = CNT[w * 32 + e]; sa += c; if (w < F.bid) sb += c; }
      partAll[part * 32 + e] = sa; partBef[part * 32 + e] = sb; }
    __syncthreads();
    if (F.tid < 32) { int sa = 0, sb = 0; for (int p = 0; p < 16; ++p) { sa += partAll[p * 32 + F.tid]; sb += partBef[p * 32 + F.tid]; } tot[F.tid] = sa; bef[F.tid] = sb; cursor[F.tid] = 0; }
    __syncthreads();
    if (F.tid == 0) { int ps = 0; int* TILE = (int*)(ws + WS_ROUTE + RT_TILE); int ti = 0;
        for (int e = 0; e < 32; ++e) { base[e] = ps + bef[e]; const int nt = (tot[e] + 255) >> 8; if (F.bid == 0) for (int t = 0; t < nt; ++t) TILE[1 + ti + t] = e; ti += nt; ps += nt * 256; }
        if (F.bid == 0) TILE[0] = ti; }
    __syncthreads();
    const int* EXPERT = (const int*)(ws + WS_ROUTE + RT_EXPERT); const float* GATE = (const float*)(ws + WS_ROUTE + RT_GATE);
    int* TOKSLOT = (int*)(ws + WS_ROUTE + RT_TOKSLOT); float* SLOTW = (float*)(ws + WS_ROUTE + RT_SLOTW);
    { const int a = F.tid; const size_t idx = (size_t)F.bid * 512 + a; const int e = EXPERT[idx]; const int rank = atomicAdd(&cursor[e], 1); const int slot = base[e] + rank;
      SLOTW[slot] = GATE[idx]; TOKSLOT[idx] = slot; slotL[a] = slot; }
    __syncthreads();
    const bf16* XN = (const bf16*)(ws + WS_XN); bf16* XS = (bf16*)(ws + WS_XS);
    for (int i = 0; i < 64; ++i) { const int a = F.wave * 64 + i; const int slot = slotL[a]; const size_t tok = (size_t)F.bid * 256 + (a >> 1);
        const v4u* src = (const v4u*)(XN + tok * 1024); v4u* dst = (v4u*)(XS + (size_t)slot * 1024);
        dst[F.lane] = src[F.lane]; dst[64 + F.lane] = src[64 + F.lane]; }
    __syncthreads();
}

__device__ __forceinline__ void combine_rows(Frame& F, int l, bool next_norm) {
    unsigned char* ws = F.ws;
    const int gw = F.bid * NWAVES + F.wave; const int m0 = gw * 32, b = m0 >> 11;
    const float* MODl = (const float*)(ws + WS_MOD) + ((size_t)l * 32 + b) * 6144;
    f32x4 gt2[4], mul[4], add[4];
#pragma unroll
    for (int j = 0; j < 4; ++j) { const int e = 4 * (F.lane + 64 * j); gt2[j] = *(const f32x4*)(MODl + 5120 + e); mul[j] = gt2[j]; add[j] = gt2[j]; }
    if (next_norm) { const float* g = F.A->in[I_N1G] + (l + 1) * 1024; const float* MODn = (const float*)(ws + WS_MOD) + ((size_t)(l + 1) * 32 + b) * 6144;
#pragma unroll
        for (int j = 0; j < 4; ++j) { const int e = 4 * (F.lane + 64 * j); const f32x4 gv = *(const f32x4*)(g + e), sc = *(const f32x4*)(MODn + 1024 + e); mul[j] = gv * (1.0f + sc); add[j] = *(const f32x4*)(MODn + e); } }
    const int* TOKSLOT = (const int*)(ws + WS_ROUTE + RT_TOKSLOT); const bf16* YS = (const bf16*)(ws + WS_XS); bf16* XN = (bf16*)(ws + WS_XN);
    for (int r = 0; r < 32; ++r) {
        const size_t m = (size_t)(m0 + r);
        const int s0 = TOKSLOT[2 * m], s1 = TOKSLOT[2 * m + 1];
        f32x4* xr = (f32x4*)(F.out + m * 1024) + F.lane;
        const u32x2v* y0 = (const u32x2v*)(YS + (size_t)s0 * 1024) + F.lane; const u32x2v* y1 = (const u32x2v*)(YS + (size_t)s1 * 1024) + F.lane;
        f32x4 v[4]; float s = 0.f;
#pragma unroll
        for (int j = 0; j < 4; ++j) { const f32x4 x = xr[64 * j]; const u32x2v a = y0[64 * j], c = y1[64 * j];
            f32x4 y; y.x = bflo(a.x) + bflo(c.x); y.y = bfhi(a.x) + bfhi(c.x); y.z = bflo(a.y) + bflo(c.y); y.w = bfhi(a.y) + bfhi(c.y);
            v[j] = x + gt2[j] * y; xr[64 * j] = v[j]; s += (v[j].x * v[j].x + v[j].y * v[j].y) + (v[j].z * v[j].z + v[j].w * v[j].w); }
        if (next_norm) {
            const float rs = rsqrtf(wave_sum(s) * (1.0f / 1024.0f) + 1e-6f);
            unsigned long long* o8 = (unsigned long long*)(XN + m * 1024) + F.lane;
#pragma unroll
            for (int j = 0; j < 4; ++j) { const f32x4 h = v[j] * rs * mul[j] + add[j]; o8[64 * j] = (unsigned long long)pk2(h.x, h.y) | ((unsigned long long)pk2(h.z, h.w) << 32); }
        }
    }
}

__device__ __forceinline__ void dsa_prep(Frame& F, int l) {
    bf16* P = (bf16*)(F.ws + WS_P); const float* rope = (const float*)(F.ws + WS_ROPE);
    const float* gq = F.A->in[I_QNG] + l * 64; const float* gk = F.A->in[I_KNG] + l * 64;
    const int gw = F.bid * NWAVES + F.wave; const int hh = F.lane >> 4, i = F.lane & 15;
    const float gq0 = gq[i], gq1 = gq[i + 16], gq2 = gq[i + 32], gq3 = gq[i + 48];
    const float gk0 = gk[i], gk1 = gk[i + 16], gk2 = gk[i + 32], gk3 = gk[i + 48];
    for (int r = 0; r < 32; ++r) {
        const size_t m = (size_t)gw * 32 + r; const int pos = (int)(m & 2047);
        bf16* row = P + m * PW; const float* rp = rope + (size_t)pos * 64;
        const float c0 = rp[2 * i], s0 = rp[2 * i + 1], c1 = rp[2 * (i + 16)], s1 = rp[2 * (i + 16) + 1];
        { bf16* q = row + D_Q + hh * 64;
          const float x0 = bf2f(q[i]), x1 = bf2f(q[i + 16]), x2 = bf2f(q[i + 32]), x3 = bf2f(q[i + 48]);
          const float rs = rsqrtf(sum16(x0 * x0 + x1 * x1 + x2 * x2 + x3 * x3) * (1.0f / 64.0f) + 1e-6f);
          const float a0 = x0 * rs * gq0, a1 = x1 * rs * gq1, a2 = x2 * rs * gq2, a3 = x3 * rs * gq3;
          q[i] = (bf16)f2bf(a0 * c0 - a2 * s0); q[i + 32] = (bf16)f2bf(a2 * c0 + a0 * s0);
          q[i + 16] = (bf16)f2bf(a1 * c1 - a3 * s1); q[i + 48] = (bf16)f2bf(a3 * c1 + a1 * s1); }
        { bf16* k = row + D_K;
          const float x0 = bf2f(k[i]), x1 = bf2f(k[i + 16]), x2 = bf2f(k[i + 32]), x3 = bf2f(k[i + 48]);
          const float rs = rsqrtf(sum16(x0 * x0 + x1 * x1 + x2 * x2 + x3 * x3) * (1.0f / 64.0f) + 1e-6f);
          const float a0 = x0 * rs * gk0, a1 = x1 * rs * gk1, a2 = x2 * rs * gk2, a3 = x3 * rs * gk3;
          const unsigned short o0 = (bf16)f2bf(a0 * c0 - a2 * s0), o2 = (bf16)f2bf(a2 * c0 + a0 * s0), o1 = (bf16)f2bf(a1 * c1 - a3 * s1), o3 = (bf16)f2bf(a3 * c1 + a1 * s1);
          asm volatile("" ::: "memory");
          if (hh == 0) { k[i] = o0; k[i + 32] = o2; k[i + 16] = o1; k[i + 48] = o3; } }
        const float ci = rp[4 * i], si = rp[4 * i + 1];
        { bf16* qi = row + D_QI + hh * 32; const float x1 = bf2f(qi[i]), x2 = bf2f(qi[i + 16]); qi[i] = (bf16)f2bf(x1 * ci - x2 * si); qi[i + 16] = (bf16)f2bf(x2 * ci + x1 * si); }
        { bf16* ki = row + D_KI; const float x1 = bf2f(ki[i]), x2 = bf2f(ki[i + 16]); const unsigned short o1 = (bf16)f2bf(x1 * ci - x2 * si), o2 = (bf16)f2bf(x2 * ci + x1 * si);
          asm volatile("" ::: "memory");
          if (hh == 0) { ki[i] = o1; ki[i + 16] = o2; } }
        if (F.lane < 4) { bf16* wi = row + D_WI; wi[F.lane] = (bf16)f2bf(bf2f(wi[F.lane]) * 0.08838834764831845f); }
    }
}

__device__ __forceinline__ void rwkv_item(Frame& F, int l, int b, int h) {
    const bf16* P = (const bf16*)(F.ws + WS_P); bf16* YC = (bf16*)(F.ws + WS_YCAT);
    float* RAW = (float*)F.lds;
    float* W2H = RAW + 32 * 320;
    float* A2H = W2H + 32 * 64;
    float* G2H = A2H + 32 * 64;
    float* VEC = G2H + 64 * 64;
    float* YS = VEC + 32 * 7 * 64;
    float* BON = YS + 32 * 64;
    float* PAR = BON + 32;
    const int tid = F.tid;
    const float* mu = F.A->in[I_MU] + l * 896;
    for (int i = tid; i < 32 * 64; i += 512) { const int j = i >> 6, c = i & 63; W2H[i] = F.A->in[I_W2][((size_t)l * 32 + j) * 256 + h * 64 + c]; A2H[i] = F.A->in[I_A2][((size_t)l * 32 + j) * 256 + h * 64 + c]; }
    for (int i = tid; i < 64 * 64; i += 512) { const int j = i >> 6, c = i & 63; G2H[i] = F.A->in[I_G2][((size_t)l * 64 + j) * 256 + h * 64 + c]; }
    if (tid < 448) { const int w = tid >> 6, c = tid & 63; const float* sp = w == 0 ? F.A->in[I_W0] : w == 1 ? F.A->in[I_A0] : w == 2 ? F.A->in[I_KK] : w == 3 ? F.A->in[I_KA] : w == 4 ? F.A->in[I_RK] : w == 5 ? F.A->in[I_LNG] : F.A->in[I_LNB]; PAR[tid] = sp[l * 256 + h * 64 + c]; }
    float S[8];
#pragma unroll
    for (int j = 0; j < 8; ++j) S[j] = 0.f;
    const int row = tid >> 3, seg = tid & 7;
    const int pt = tid >> 4, cg = tid & 15;
    __syncthreads();
    for (int t0 = 0; t0 < SEQ; t0 += 32) {
        for (int i = 0; i < 20; ++i) { const int idx = tid + 512 * i; const int t = idx / 320, col = idx % 320;
            const int pc = col < 64 ? A_R + h * 64 + col : col < 128 ? A_K + h * 64 + (col - 64) : col < 192 ? A_V + h * 64 + (col - 128) : col < 224 ? A_WD + (col - 192) : col < 256 ? A_AD + (col - 224) : A_GD + (col - 256);
            const size_t m = (size_t)b * SEQ + t0 + t; const float cur = bf2f(P[m * PW + pc]); const float prev = (t0 + t > 0) ? bf2f(P[(m - 1) * PW + pc]) : 0.f;
            float v = cur + (prev - cur) * mu[pc];
            if (col >= 192 && col < 224) v = tanhf(v); else if (col >= 256) v = sigmoidf_(v);
            RAW[idx] = v; }
        __syncthreads();
        { const float* rw = RAW + pt * 320; f32x4 wv = *(const f32x4*)(PAR + 4 * cg), av = *(const f32x4*)(PAR + 64 + 4 * cg), gv = {0.f, 0.f, 0.f, 0.f};
#pragma unroll 8
          for (int j = 0; j < 32; ++j) { wv += rw[192 + j] * *(const f32x4*)(W2H + j * 64 + 4 * cg); av += rw[224 + j] * *(const f32x4*)(A2H + j * 64 + 4 * cg); }
#pragma unroll 8
          for (int j = 0; j < 64; ++j) gv += rw[256 + j] * *(const f32x4*)(G2H + j * 64 + 4 * cg);
          const f32x4 rr = *(const f32x4*)(rw + 4 * cg), kk0 = *(const f32x4*)(rw + 64 + 4 * cg), vv = *(const f32x4*)(rw + 128 + 4 * cg);
          const f32x4 k_k = *(const f32x4*)(PAR + 128 + 4 * cg), k_a = *(const f32x4*)(PAR + 192 + 4 * cg), r_k = *(const f32x4*)(PAR + 256 + 4 * cg);
          f32x4 dec, aa, kkr, kmod; float n2 = 0.f, bon = 0.f;
#pragma unroll
          for (int i = 0; i < 4; ++i) { const float w = -softplusf_(-wv[i]) - 0.5f; dec[i] = __expf(-__expf(w)); aa[i] = sigmoidf_(av[i]); kkr[i] = kk0[i] * k_k[i]; n2 += kkr[i] * kkr[i];
              kmod[i] = kk0[i] * (1.0f + (aa[i] - 1.0f) * k_a[i]); bon += rr[i] * kmod[i] * r_k[i]; }
          n2 = sum16(n2); bon = sum16(bon);
          const float inv = 1.0f / fmaxf(sqrtf(n2), 1e-12f);
          float* ve = VEC + pt * 448 + 4 * cg;
          const f32x4 kkn = kkr * inv;
          *(f32x4*)(ve) = dec; *(f32x4*)(ve + 64) = kkn; *(f32x4*)(ve + 128) = kkn * aa; *(f32x4*)(ve + 192) = kmod; *(f32x4*)(ve + 256) = rr; *(f32x4*)(ve + 320) = vv; *(f32x4*)(ve + 384) = gv;
          if (cg == 0) BON[pt] = bon; }
        __syncthreads();
        for (int t = 0; t < 32; ++t) {
            const float* ve = VEC + t * 448 + seg * 8;
            const f32x4 d0 = *(const f32x4*)(ve), d1 = *(const f32x4*)(ve + 4), q0 = *(const f32x4*)(ve + 64), q1 = *(const f32x4*)(ve + 68), b0 = *(const f32x4*)(ve + 128), b1 = *(const f32x4*)(ve + 132),
                        m0 = *(const f32x4*)(ve + 192), m1 = *(const f32x4*)(ve + 196), r0 = *(const f32x4*)(ve + 256), r1 = *(const f32x4*)(ve + 260);
            const float vv = VEC[t * 448 + 320 + row];
            float sa = (S[0] * q0[0] + S[1] * q0[1]) + (S[2] * q0[2] + S[3] * q0[3]) + (S[4] * q1[0] + S[5] * q1[1]) + (S[6] * q1[2] + S[7] * q1[3]);
            sa = -sum8(sa);
#pragma unroll
            for (int j = 0; j < 4; ++j) { S[j] = S[j] * d0[j] + sa * b0[j] + vv * m0[j]; S[4 + j] = S[4 + j] * d1[j] + sa * b1[j] + vv * m1[j]; }
            float y = (S[0] * r0[0] + S[1] * r0[1]) + (S[2] * r0[2] + S[3] * r0[3]) + (S[4] * r1[0] + S[5] * r1[1]) + (S[6] * r1[2] + S[7] * r1[3]);
            y = sum8(y);
            if (seg == 0) YS[t * 64 + row] = y;
        }
        __syncthreads();
        { const f32x4 y = *(const f32x4*)(YS + pt * 64 + 4 * cg); const float mean = sum16((y[0] + y[1]) + (y[2] + y[3])) * (1.0f / 64.0f); const f32x4 d = y - mean;
          const float var = sum16((d[0] * d[0] + d[1] * d[1]) + (d[2] * d[2] + d[3] * d[3])) * (1.0f / 64.0f); const float rs = rsqrtf(var + 64e-5f);
          const f32x4 lg = *(const f32x4*)(PAR + 320 + 4 * cg), lb = *(const f32x4*)(PAR + 384 + 4 * cg);
          const float* ve = VEC + pt * 448 + 4 * cg; const f32x4 vv = *(const f32x4*)(ve + 320), gg = *(const f32x4*)(ve + 384);
          const f32x4 o = (d * rs * lg + lb + BON[pt] * vv) * gg;
          u32x2v w; w.x = pk2(o[0], o[1]); w.y = pk2(o[2], o[3]);
          *(u32x2v*)(YC + ((size_t)b * SEQ + t0 + pt) * 1024 + h * 64 + 4 * cg) = w; }
        __syncthreads();
    }
}

__device__ __forceinline__ void mlstm_item(Frame& F, int l, int b, int h) {
    const bf16* P = (const bf16*)(F.ws + WS_P); bf16* YC = (bf16*)(F.ws + WS_YCAT);
    float* VEC = (float*)F.lds;
    float* HS = VEC + 32 * 256;
    float* GT = HS + 32 * 64;
    float* LIF = GT + 128;
    const int tid = F.tid;
    const float* cw = F.A->in[I_CONVW] + (size_t)l * 4 * 512; const float* cb = F.A->in[I_CONVB] + l * 512;
    const float igb = F.A->in[I_IGB][l * 4 + h], fgb = F.A->in[I_FGB][l * 4 + h];
    float C[8], n[8];
#pragma unroll
    for (int j = 0; j < 8; ++j) { C[j] = 0.f; n[j] = 0.f; }
    float mrun = 0.f;
    const int row = tid >> 3, seg = tid & 7, pt = tid >> 4, cg = tid & 15;
    for (int t0 = 0; t0 < SEQ; t0 += 32) {
        for (int i = 0; i < 8; ++i) { const int idx = tid + 512 * i; const int t = idx >> 7, col = idx & 127, which = col >> 6, c = col & 63;
            const int ch = which * 256 + h * 64 + c; const int pc = (which ? C_K : C_Q) + h * 64 + c; const size_t m = (size_t)b * SEQ + t0 + t;
            float acc = cb[ch];
#pragma unroll
            for (int j = 0; j < 4; ++j) { const int tt = t0 + t - 3 + j; if (tt >= 0) acc += cw[j * 512 + ch] * bf2f(P[(m - 3 + j) * PW + pc]); }
            float v = acc * sigmoidf_(acc); if (which) v *= 0.125f;
            VEC[t * 256 + which * 64 + c] = v;
            const float pv = bf2f(P[m * PW + (which ? C_O : C_V) + h * 64 + c]);
            VEC[t * 256 + 128 + which * 64 + c] = which ? sigmoidf_(pv) : pv; }
        if (tid < 32) { const size_t m = (size_t)b * SEQ + t0 + tid; const float ig = bf2f(P[m * PW + C_I + h]) + igb, fg = bf2f(P[m * PW + C_F + h]) + fgb;
            const float li = 15.0f * tanhf(ig * (1.0f / 15.0f)); const float fc = 15.0f * tanhf(fg * (1.0f / 15.0f)); LIF[2 * tid] = li; LIF[2 * tid + 1] = -softplusf_(-fc); }
        __syncthreads();
        if (tid == 0) { for (int t = 0; t < 32; ++t) { const float li = LIF[2 * t], lf = LIF[2 * t + 1]; const float mn = fmaxf(lf + mrun, li); GT[4 * t] = __expf(lf + mrun - mn); GT[4 * t + 1] = __expf(li - mn); GT[4 * t + 2] = __expf(-mn); mrun = mn; } }
        __syncthreads();
        for (int t = 0; t < 32; ++t) {
            const float* ve = VEC + t * 256 + seg * 8;
            const f32x4 q0 = *(const f32x4*)(ve), q1 = *(const f32x4*)(ve + 4), k0 = *(const f32x4*)(ve + 64), k1 = *(const f32x4*)(ve + 68);
            const float vv = VEC[t * 256 + 128 + row]; const float fs = GT[4 * t], is = GT[4 * t + 1], em = GT[4 * t + 2];
            const float iv = is * vv;
#pragma unroll
            for (int j = 0; j < 4; ++j) { C[j] = fs * C[j] + iv * k0[j]; C[4 + j] = fs * C[4 + j] + iv * k1[j]; n[j] = fs * n[j] + is * k0[j]; n[4 + j] = fs * n[4 + j] + is * k1[j]; }
            float num = (C[0] * q0[0] + C[1] * q0[1]) + (C[2] * q0[2] + C[3] * q0[3]) + (C[4] * q1[0] + C[5] * q1[1]) + (C[6] * q1[2] + C[7] * q1[3]);
            float den = (n[0] * q0[0] + n[1] * q0[1]) + (n[2] * q0[2] + n[3] * q0[3]) + (n[4] * q1[0] + n[5] * q1[1]) + (n[6] * q1[2] + n[7] * q1[3]);
            num = sum8(num); den = sum8(den);
            if (seg == 0) HS[t * 64 + row] = num / fmaxf(fabsf(den), em);
        }
        __syncthreads();
        { const f32x4 hv = *(const f32x4*)(HS + pt * 64 + 4 * cg); const float ms = sum16((hv[0] * hv[0] + hv[1] * hv[1]) + (hv[2] * hv[2] + hv[3] * hv[3])) * (1.0f / 64.0f); const float rs = rsqrtf(ms + 1e-6f);
          const f32x4 g = *(const f32x4*)(F.A->in[I_MLG] + l * 256 + h * 64 + 4 * cg); const f32x4 og = *(const f32x4*)(VEC + pt * 256 + 192 + 4 * cg);
          const f32x4 o = og * (hv * rs * g);
          u32x2v w; w.x = pk2(o[0], o[1]); w.y = pk2(o[2], o[3]);
          *(u32x2v*)(YC + ((size_t)b * SEQ + t0 + pt) * 1024 + 512 + h * 64 + 4 * cg) = w; }
        __syncthreads();
    }
}

__device__ __forceinline__ void sb_item(Frame& F, int l, int b, int h, int qg) {
    const bf16* P = (const bf16*)(F.ws + WS_P); bf16* YC = (bf16*)(F.ws + WS_YCAT);
    const int t0w = __builtin_amdgcn_readfirstlane(qg * 512 + F.wave * 64); const int t = t0w + F.lane;
    const size_t mrow = (size_t)b * SEQ + t;
    float q[64], o[64];
    { const v4u* qp = (const v4u*)(P + mrow * PW + B_Q + h * 64);
#pragma unroll
      for (int i = 0; i < 8; ++i) { const v4u w = qp[i]; q[8 * i] = bflo(w.x) * 0.125f; q[8 * i + 1] = bfhi(w.x) * 0.125f; q[8 * i + 2] = bflo(w.y) * 0.125f; q[8 * i + 3] = bfhi(w.y) * 0.125f;
          q[8 * i + 4] = bflo(w.z) * 0.125f; q[8 * i + 5] = bfhi(w.z) * 0.125f; q[8 * i + 6] = bflo(w.w) * 0.125f; q[8 * i + 7] = bfhi(w.w) * 0.125f; } }
#pragma unroll
    for (int d = 0; d < 64; ++d) o[d] = 0.f;
    float cs = 0.f;
    for (int s = t0w + 62; s >= 0; --s) {
        const bf16* kr = P + ((size_t)b * SEQ + s) * PW + B_K + h * 64; const bf16* vr = P + ((size_t)b * SEQ + s) * PW + B_V + h * 64;
        float z0 = 0.f, z1 = 0.f;
#pragma unroll
        for (int i = 0; i < 8; ++i) { const v4u w = ((const v4u*)kr)[i];
            z0 += q[8 * i] * bflo(w.x) + q[8 * i + 2] * bflo(w.y) + q[8 * i + 4] * bflo(w.z) + q[8 * i + 6] * bflo(w.w);
            z1 += q[8 * i + 1] * bfhi(w.x) + q[8 * i + 3] * bfhi(w.y) + q[8 * i + 5] * bfhi(w.z) + q[8 * i + 7] * bfhi(w.w); }
        const float z = z0 + z1; const bool valid = s < t;
        const float sp = softplusf_(z);
        const float a = valid ? __expf((z - sp) + cs) : 0.f;
#pragma unroll
        for (int i = 0; i < 8; ++i) { const v4u w = ((const v4u*)vr)[i];
            o[8 * i] += a * bflo(w.x); o[8 * i + 1] += a * bfhi(w.x); o[8 * i + 2] += a * bflo(w.y); o[8 * i + 3] += a * bfhi(w.y);
            o[8 * i + 4] += a * bflo(w.z); o[8 * i + 5] += a * bfhi(w.z); o[8 * i + 6] += a * bflo(w.w); o[8 * i + 7] += a * bfhi(w.w); }
        if (valid) cs -= sp;
        if (s < t0w && __all(cs < -120.0f)) break;
    }
    float ms = 0.f;
#pragma unroll
    for (int d = 0; d < 64; ++d) ms += o[d] * o[d];
    const float rs = rsqrtf(ms * (1.0f / 64.0f) + 1e-6f);
    const float* g = F.A->in[I_SBG] + l * 256 + h * 64;
    v4u* op = (v4u*)(YC + mrow * 1024 + 256 + h * 64);
#pragma unroll
    for (int i = 0; i < 8; ++i) { v4u w; w.x = pk2(o[8 * i] * rs * g[8 * i], o[8 * i + 1] * rs * g[8 * i + 1]); w.y = pk2(o[8 * i + 2] * rs * g[8 * i + 2], o[8 * i + 3] * rs * g[8 * i + 3]);
        w.z = pk2(o[8 * i + 4] * rs * g[8 * i + 4], o[8 * i + 5] * rs * g[8 * i + 5]); w.w = pk2(o[8 * i + 6] * rs * g[8 * i + 6], o[8 * i + 7] * rs * g[8 * i + 7]); op[i] = w; }
}

__device__ __forceinline__ unsigned sortable(float v) { const unsigned u = __float_as_uint(v); return u ^ ((u >> 31) ? 0xffffffffu : 0x80000000u); }
__device__ __forceinline__ int wave_isum(int v) {
#pragma unroll
    for (int o = 1; o < 64; o <<= 1) v += __shfl_xor(v, o);
    return v;
}
__device__ __forceinline__ void dsa_item(Frame& F, int l, int b, int qblk) {
    const bf16* P = (const bf16*)(F.ws + WS_P); bf16* YC = (bf16*)(F.ws + WS_YCAT);
    float* SC = (float*)F.lds;
    unsigned* MASKL = (unsigned*)(F.lds + 65536);
    const int lane = F.lane, wave = F.wave, hi = lane >> 5, r32 = lane & 31;
    const size_t brow = (size_t)b * SEQ;
    for (int rd = 0; rd < 16; ++rd) {
        const int tq0 = qblk * 128 + rd * 8; const int nkt = (tq0 + 8 + 31) >> 5;
        { const int hh = r32 >> 3, qq = r32 & 7;
          const bf16* ap = P + (brow + tq0 + qq) * PW + D_QI + hh * 32 + 8 * hi;
          const bf16x8 a0 = *(const bf16x8*)(ap), a1 = *(const bf16x8*)(ap + 16);
          float wv[4][4];
#pragma unroll
          for (int j = 0; j < 4; ++j) { const u32x2v w = *(const u32x2v*)(P + (brow + tq0 + j + 4 * hi) * PW + D_WI); wv[0][j] = bflo(w.x); wv[1][j] = bfhi(w.x); wv[2][j] = bflo(w.y); wv[3][j] = bfhi(w.y); }
          for (int kt = wave; kt < nkt; kt += 8) {
              const int key = kt * 32 + r32; const bf16* bp = P + (brow + key) * PW + D_KI + 8 * hi;
              const bf16x8 b0 = *(const bf16x8*)(bp), b1 = *(const bf16x8*)(bp + 16);
              f32x16 acc = {0.f, 0.f, 0.f, 0.f, 0.f, 0.f, 0.f, 0.f, 0.f, 0.f, 0.f, 0.f, 0.f, 0.f, 0.f, 0.f};
              acc = __builtin_amdgcn_mfma_f32_32x32x16_bf16(a0, b0, acc, 0, 0, 0);
              acc = __builtin_amdgcn_mfma_f32_32x32x16_bf16(a1, b1, acc, 0, 0, 0);
#pragma unroll
              for (int j = 0; j < 4; ++j) { float s = wv[0][j] * fmaxf(acc[j], 0.f); s = fmaf(wv[1][j], fmaxf(acc[4 + j], 0.f), s); s = fmaf(wv[2][j], fmaxf(acc[8 + j], 0.f), s); s = fmaf(wv[3][j], fmaxf(acc[12 + j], 0.f), s);
                  SC[(j + 4 * hi) * 2048 + key] = s; }
          } }
        __syncthreads();
        { const int t = tq0 + wave; const int ql = rd * 8 + wave; unsigned* mrow = MASKL + ql * 64;
          if (t < 256) { const unsigned w = (lane * 32 + 31 <= t) ? 0xffffffffu : (lane * 32 > t) ? 0u : (0xffffffffu >> (31 - (t - lane * 32))); mrow[lane] = w; }
          else {
              unsigned u[32];
#pragma unroll
              for (int i = 0; i < 32; ++i) { const int key = lane + 64 * i; u[i] = (key <= t) ? sortable(SC[wave * 2048 + key]) : 0u; }
              unsigned T = 0u;
              for (int bit = 31; bit >= 0; --bit) { const unsigned cand = T | (1u << bit); int c = 0;
#pragma unroll
                  for (int i = 0; i < 32; ++i) c += (u[i] >= cand) ? 1 : 0;
                  c = wave_isum(c); if (c >= 256) T = cand; }
              int cgt = 0;
#pragma unroll
              for (int i = 0; i < 32; ++i) cgt += (u[i] > T) ? 1 : 0;
              cgt = wave_isum(cgt); const int need = 256 - cgt; int acce = 0; unsigned mylo = 0u;
#pragma unroll
              for (int i = 0; i < 32; ++i) { const bool eq = (u[i] == T); const unsigned long long ball = __ballot(eq);
                  const int pre = __builtin_amdgcn_mbcnt_hi((unsigned)(ball >> 32), __builtin_amdgcn_mbcnt_lo((unsigned)ball, 0u));
                  const bool sel = (u[i] > T) || (eq && (acce + pre < need)); acce += __popcll(ball);
                  const unsigned long long sb = __ballot(sel);
                  if (lane == 2 * i) mylo = (unsigned)sb; if (lane == 2 * i + 1) mylo = (unsigned)(sb >> 32); }
              mrow[lane] = mylo; } }
        __syncthreads();
    }
    { const int ql = wave * 16 + (lane >> 2), hh = lane & 3; const int t = qblk * 128 + ql; const size_t mrow = brow + t;
      const int tmax = __builtin_amdgcn_readfirstlane(qblk * 128 + wave * 16 + 15);
      float gqm = 0.f, gkm = 0.f;
      for (int d = 0; d < 64; ++d) { gqm = fmaxf(gqm, fabsf(F.A->in[I_QNG][l * 64 + d])); gkm = fmaxf(gkm, fabsf(F.A->in[I_KNG][l * 64 + d])); }
      const float cbound = 8.0f * gqm * gkm;
      float q[64], o[64];
      { const v4u* qp = (const v4u*)(P + mrow * PW + D_Q + hh * 64);
#pragma unroll
        for (int i = 0; i < 8; ++i) { const v4u w = qp[i]; q[8 * i] = bflo(w.x) * 0.125f; q[8 * i + 1] = bfhi(w.x) * 0.125f; q[8 * i + 2] = bflo(w.y) * 0.125f; q[8 * i + 3] = bfhi(w.y) * 0.125f;
            q[8 * i + 4] = bflo(w.z) * 0.125f; q[8 * i + 5] = bfhi(w.z) * 0.125f; q[8 * i + 6] = bflo(w.w) * 0.125f; q[8 * i + 7] = bfhi(w.w) * 0.125f; } }
#pragma unroll
      for (int d = 0; d < 64; ++d) o[d] = 0.f;
      float lsum = 0.f; const unsigned* mq = MASKL + ql * 64;
      for (int s = 0; s <= tmax; ++s) {
          const unsigned word = mq[s >> 5]; const bool sel = (word >> (s & 31)) & 1u;
          if (__ballot(sel) == 0ull) continue;
          const bf16* kr = P + (brow + s) * PW + D_K; const bf16* vr = P + (brow + s) * PW + D_V;
          float z0 = 0.f, z1 = 0.f;
#pragma unroll
          for (int i = 0; i < 8; ++i) { const v4u w = ((const v4u*)kr)[i];
              z0 += q[8 * i] * bflo(w.x) + q[8 * i + 2] * bflo(w.y) + q[8 * i + 4] * bflo(w.z) + q[8 * i + 6] * bflo(w.w);
              z1 += q[8 * i + 1] * bfhi(w.x) + q[8 * i + 3] * bfhi(w.y) + q[8 * i + 5] * bfhi(w.z) + q[8 * i + 7] * bfhi(w.w); }
          const float p = sel ? __expf((z0 + z1) - cbound) : 0.f; lsum += p;
#pragma unroll
          for (int i = 0; i < 8; ++i) { const v4u w = ((const v4u*)vr)[i];
              o[8 * i] += p * bflo(w.x); o[8 * i + 1] += p * bfhi(w.x); o[8 * i + 2] += p * bflo(w.y); o[8 * i + 3] += p * bfhi(w.y);
              o[8 * i + 4] += p * bflo(w.z); o[8 * i + 5] += p * bfhi(w.z); o[8 * i + 6] += p * bflo(w.w); o[8 * i + 7] += p * bfhi(w.w); }
      }
      const float il = 1.0f / lsum; float ms = 0.f;
#pragma unroll
      for (int d = 0; d < 64; ++d) { o[d] *= il; ms += o[d] * o[d]; }
      const float rs = rsqrtf(ms * (1.0f / 64.0f) + 1e-6f);
      const float* g = F.A->in[I_DOG] + l * 256 + hh * 64;
      v4u* op = (v4u*)(YC + mrow * 1024 + 768 + hh * 64);
#pragma unroll
      for (int i = 0; i < 8; ++i) { v4u w; w.x = pk2(o[8 * i] * rs * g[8 * i], o[8 * i + 1] * rs * g[8 * i + 1]); w.y = pk2(o[8 * i + 2] * rs * g[8 * i + 2], o[8 * i + 3] * rs * g[8 * i + 3]);
          w.z = pk2(o[8 * i + 4] * rs * g[8 * i + 4], o[8 * i + 5] * rs * g[8 * i + 5]); w.w = pk2(o[8 * i + 6] * rs * g[8 * i + 6], o[8 * i + 7] * rs * g[8 * i + 7]); op[i] = w; } }
    __syncthreads();
}

#define REFRESH() do { int t_ = threadIdx.x; asm volatile("" : "+v"(t_)); F.tid = t_; F.lane = t_ & 63; F.wave = __builtin_amdgcn_readfirstlane(t_ >> 6); } while (0)
__device__ __forceinline__ void mixers_phase(Frame& F, int l) {
    volatile int* qslot = (volatile int*)(F.lds + MISC_OFF + 64);
    for (;;) {
        __syncthreads();
        if (F.tid == 0) *qslot = (int)__hip_atomic_fetch_add((unsigned*)(F.ctl + CW_Q + 64 * l), 1u, __ATOMIC_RELAXED, __HIP_MEMORY_SCOPE_AGENT);
        __syncthreads();
        const int it = __builtin_amdgcn_readfirstlane(*qslot);
        if (it >= 1280) break;
        if (it < 128) { if (PHE(11)) { REFRESH(); rwkv_item(F, l, it >> 2, it & 3); } }
        else if (it < 256) { if (PHE(12)) { REFRESH(); mlstm_item(F, l, (it - 128) >> 2, (it - 128) & 3); } }
        else if (it < 768) { const int j = it - 256; if (PHE(13)) { REFRESH(); dsa_item(F, l, j & 31, 15 - (j >> 5)); } }
        else { const int j = it - 768; if (PHE(14)) { REFRESH(); sb_item(F, l, j >> 4, (j >> 2) & 3, j & 3); } }
    }
}

constexpr int PH_PER_LAYER = 10, N_PHASES = 1 + PH_PER_LAYER * DEPTH;
__global__ void __launch_bounds__(NWAVES * 64, 2) mk_fwd(Args args) {
    extern __shared__ __attribute__((aligned(16))) unsigned char lds[];
    Frame F;
    F.lds = lds;
    F.tid = threadIdx.x; F.lane = F.tid & 63; F.wave = __builtin_amdgcn_readfirstlane(F.tid >> 6);
    F.G = gridDim.x; F.bid = blockIdx.x; { const int bx = blockIdx.x; F.vcu = (F.G % 8 == 0) ? (bx % 8) * (F.G / 8) + bx / 8 : bx; }
    F.ws = args.ws; F.out = args.out; F.ctl = (gu32*)(args.ws + WS_CTL);
    F.A = &args;
    volatile LAS unsigned* MISC = (volatile LAS unsigned*)((LAS unsigned char*)lds + MISC_OFF);
    for (int u = F.tid; u < (LDS_BYTES - MISC_OFF) / 4; u += NWAVES * 64) MISC[u] = 0u;
    __syncthreads();
    const int lo = args.ph_lo, hi = args.ph_hi;
    const bool multi = (hi - lo) > 1;
    XcdBarrier bar; bar.bar = (unsigned*)(F.ctl + CW_BAR); bar.x = 0; bar.st = nullptr;
    if (multi) bar = xcd_barrier_post((unsigned*)(F.ctl + CW_BAR), MISC + 8);
#define IN(k) (lo <= (k) && (k) < hi)
#define PB() do { int t_ = threadIdx.x; asm volatile("" : "+v"(t_)); F.tid = t_; F.lane = t_ & 63; F.wave = __builtin_amdgcn_readfirstlane(t_ >> 6); int b_ = blockIdx.x; asm volatile("" : "+s"(b_)); F.bid = b_; } while (0)
#define SEAM(k) do { if (IN(k) && IN((k) + 1)) xcd_barrier(bar); } while (0)
    LAS unsigned char* ldsl = (LAS unsigned char*)lds;
    bf16* XN = (bf16*)(F.ws + WS_XN); bf16* Pb = (bf16*)(F.ws + WS_P); bf16* YC = (bf16*)(F.ws + WS_YCAT);

    if (PHE(0) && IN(0)) { PB(); p0_prologue(F); }
    SEAM(0);
    for (int l = 0; l < DEPTH; ++l) {
        const int pb = 1 + PH_PER_LAYER * l;
        if (PHE(1) && IN(pb + 0)) { PB(); if (l == 0) norm_rows(F, F.A->in[I_X], 0, 0); }
        if (l == 0) SEAM(pb + 0);
        if (PHE(2) && IN(pb + 1)) { PB();
            pg8::Gemm g{1024}; pg8::DenseOrder S; S.init(XN, (const bf16*)(F.ws + WS_WIN) + (size_t)l * PW * 1024, NTOK, PW, 1024, F.G, F.bid);
            pg8::EpiBf16 E{Pb, PW};
            pg8::gemm_phase<pg8::EpiBf16, pg8::DenseOrder, true, true>(ldsl, g, S, E, F.tid);
        }
        SEAM(pb + 1);
        if (PHE(3) && IN(pb + 2)) { PB(); dsa_prep(F, l); }
        SEAM(pb + 2);
        if (PHE(4) && IN(pb + 3)) { PB(); mixers_phase(F, l); }
        SEAM(pb + 3);
        if (PHE(5) && IN(pb + 4)) { PB();
            pg8::Gemm g{1024}; pg8::DenseOrder S; S.init(YC, (const bf16*)(F.ws + WS_WOUT) + (size_t)l * 1024 * 1024, NTOK, 1024, 1024, F.G, F.bid);
            pg8::EpiRes E{l == 0 ? F.A->in[I_X] : (const float*)F.out, F.out, (const float*)(F.ws + WS_MOD) + (size_t)l * 32 * 6144 + 2048};
            pg8::gemm_phase<pg8::EpiRes, pg8::DenseOrder, true, true>(ldsl, g, S, E, F.tid);
        }
        SEAM(pb + 4);
        if (PHE(6) && IN(pb + 5)) { PB(); norm2_route(F, l); }
        SEAM(pb + 5);
        if (PHE(7) && IN(pb + 6)) { PB(); slot_gather(F); }
        SEAM(pb + 6);
        if (PHE(8) && IN(pb + 7)) { PB();
            const int* TILE = (const int*)(F.ws + WS_ROUTE + RT_TILE); const int ntiles = TILE[0];
            pg8::Gemm g{1024}; pg8::MoeOrder S; S.ntiles = ntiles; S.nN = 4; S.nwg = ntiles * 4; S.G = F.G; S.c = F.bid; S.tile_e = TILE + 1;
            S.A = (const char*)(F.ws + WS_XS); S.W = (const char*)(F.ws + WS_W13) + (size_t)l * 32 * 1024 * 1024 * 2; S.a_tile = (size_t)256 * 1024 * 2; S.w_exp = (size_t)1024 * 1024 * 2; S.w_tile = (size_t)256 * 1024 * 2;
            pg8::EpiSwiGLU E{(bf16*)(F.ws + WS_H)};
            pg8::gemm_phase<pg8::EpiSwiGLU, pg8::MoeOrder, true, true>(ldsl, g, S, E, F.tid);
        }
        SEAM(pb + 7);
        if (PHE(9) && IN(pb + 8)) { PB();
            const int* TILE = (const int*)(F.ws + WS_ROUTE + RT_TILE); const int ntiles = TILE[0];
            pg8::Gemm g{512}; pg8::MoeOrder S; S.ntiles = ntiles; S.nN = 4; S.nwg = ntiles * 4; S.G = F.G; S.c = F.bid; S.tile_e = TILE + 1;
            S.A = (const char*)(F.ws + WS_H); S.W = (const char*)(F.ws + WS_W2) + (size_t)l * 32 * 1024 * 512 * 2; S.a_tile = (size_t)256 * 512 * 2; S.w_exp = (size_t)1024 * 512 * 2; S.w_tile = (size_t)256 * 512 * 2;
            pg8::EpiGate E{(bf16*)(F.ws + WS_XS), (const float*)(F.ws + WS_ROUTE + RT_SLOTW)};
            pg8::gemm_phase<pg8::EpiGate, pg8::MoeOrder, true, true>(ldsl, g, S, E, F.tid);
        }
        SEAM(pb + 8);
        if (PHE(10) && IN(pb + 9)) { PB(); combine_rows(F, l, l + 1 < DEPTH); }
        SEAM(pb + 9);
    }
#undef IN
#undef SEAM
}

extern "C" void kernel_launch(void* const* d_in, const int* in_sizes, int n_in, void* d_out, int out_size, void* d_ws, size_t ws_size, hipStream_t stream) {
    static int grid = 0;
    if (grid == 0) {
        if (n_in != 35 || out_size != NTOK * DM || ws_size < WS_END) { fprintf(stderr, "kernel_launch: unexpected shapes (n_in %d out %d ws %zu)\n", n_in, out_size, ws_size); grid = -1; return; }
        int dev = 0, cus = 0;
        if (hipGetDevice(&dev) != hipSuccess || hipDeviceGetAttribute(&cus, hipDeviceAttributeMultiprocessorCount, dev) != hipSuccess) { grid = -1; return; }
        if (hipFuncSetAttribute((const void*)mk_fwd, hipFuncAttributeMaxDynamicSharedMemorySize, LDS_BYTES) != hipSuccess) { fprintf(stderr, "kernel_launch: hipFuncSetAttribute failed\n"); grid = -1; return; }
        (void)hipGetLastError();
        grid = cus;
        if (grid != 256) { fprintf(stderr, "kernel_launch: built for 256 CUs, got %d\n", grid); grid = 256; }
    }
    if (grid < 0) return;
    (void)hipMemsetAsync((char*)d_ws + WS_CTL, 0, CTL_ZERO_BYTES, stream);
    Args a{};
    for (int i = 0; i < 35; ++i) a.in[i] = (const float*)d_in[i];
    a.out = (float*)d_out; a.ws = (unsigned char*)d_ws;
#if MK_ONE_LAUNCH
    a.ph_lo = 0; a.ph_hi = N_PHASES;
    hipLaunchKernelGGL(mk_fwd, dim3(grid), dim3(NWAVES * 64), LDS_BYTES, stream, a);
#else
    for (int p = 0; p < N_PHASES; ++p) { if (p == 1 + PH_PER_LAYER) continue; a.ph_lo = p; a.ph_hi = p + 1; hipLaunchKernelGGL(mk_fwd, dim3(grid), dim3(NWAVES * 64), LDS_BYTES, stream, a); }
#endif
}
```

```cpp
#include <hip/hip_runtime.h>
#include <cstdio>
#include <cstdint>

#ifndef MK_ONE_LAUNCH
#define MK_ONE_LAUNCH 1
#endif

namespace pg8 {
#define PG8_LAS __attribute__((address_space(3)))
typedef unsigned short bf16_t;
typedef short bf16x8 __attribute__((ext_vector_type(8)));
typedef float f32x4 __attribute__((ext_vector_type(4)));
typedef unsigned u32x4 __attribute__((ext_vector_type(4)));
typedef unsigned u32x2 __attribute__((ext_vector_type(2)));
constexpr int BM = 256, BK = 64, HALF = 128, HTB = HALF * BK * 2  , STAGE_BYTES = 8 * HTB, NXCD = 8, WGM = 8;

__host__ __device__ __forceinline__ int lds_byte(int r, int c) { const int st = (r >> 4) * 2 + (c >> 5), rr = r & 15, cc = c & 31, ob = rr * 64 + cc * 2; return st * 1024 + (ob ^ (((ob >> 9) & 1) << 5)); }
__host__ __device__ __forceinline__ void stage_rc(int b, int& R, int& C) { const int st = b / 1024, sb = b % 1024, swz = sb ^ (((sb >> 9) & 1) << 5); R = (st >> 1) * 16 + swz / 64; C = (st & 1) * 32 + (swz % 64) / 2; }
__host__ __device__ __forceinline__ int perm32(int rho) { const int n = rho >> 4, i = rho & 15; return 8 * (i >> 2) + 4 * n + (i & 3); }

struct Unit { int pm, pn; const char* a; const char* b; };
struct Gemm { int K; };

__device__ __forceinline__ int xcd_remap(int wgid, int nwg) { const int q = nwg / NXCD, r = nwg % NXCD, xcd = wgid % NXCD, off = wgid / NXCD; return (xcd < r ? xcd * (q + 1) : r * (q + 1) + (xcd - r) * q) + off; }

struct DenseOrder {
    int nM, nN, nwg, G, c; const char* A; const char* Bt; size_t tstep;
    __device__ __forceinline__ void init(const void* A_, const void* Bt_, int M, int N, int K, int G_, int c_) { A = (const char*)A_; Bt = (const char*)Bt_; nM = M / BM; nN = N / BM; nwg = nM * nN; G = G_; c = c_; tstep = (size_t)BM * K * 2; }
    __device__ __forceinline__ bool next(int i, Unit& u) const {
        const long L = (long)i * G + c; if (L >= nwg) return false;
        const int wgid = xcd_remap((int)L, nwg);
        const int nig = WGM * nN, gid = wgid / nig, fm = gid * WGM, gsz = (nM - fm) < WGM ? (nM - fm) : WGM;
        u.pm = fm + ((wgid % nig) % gsz); u.pn = (wgid % nig) / gsz; u.a = A + (size_t)u.pm * tstep; u.b = Bt + (size_t)u.pn * tstep; return true;
    }
    __device__ __forceinline__ void a_ready(const Unit&) const {}
    __device__ __forceinline__ void done(const Unit&) const {}
};
struct MoeOrder {
    int ntiles, nN, nwg, G, c; const int* tile_e; const char* A; const char* W; size_t a_tile, w_exp, w_tile;
    __device__ __forceinline__ bool next(int i, Unit& u) const {
        const long L = (long)i * G + c; if (L >= nwg) return false;
        const int wgid = xcd_remap((int)L, nwg);
        const int ti = wgid / nN, pn = wgid % nN; const int e = tile_e[ti];
        u.pm = ti; u.pn = pn; u.a = A + (size_t)ti * a_tile; u.b = W + (size_t)e * w_exp + (size_t)pn * w_tile; return true;
    }
    __device__ __forceinline__ void a_ready(const Unit&) const {}
    __device__ __forceinline__ void done(const Unit&) const {}
};

__device__ __forceinline__ unsigned cvt_pk_bf16(float lo, float hi) { unsigned r; asm volatile("v_cvt_pk_bf16_f32 %0, %1, %2" : "=v"(r) : "v"(lo), "v"(hi)); return r; }

struct EpiBf16 {
    static constexpr bool PERM = true, AFTER_DRAIN = false;
    bf16_t* O; int ldc;
    __device__ __forceinline__ void operator()(const f32x4 (&acc)[2][2][4][2], const Unit& u, int wr, int wc, int fr, int fq) const {
        const int row0 = u.pm * BM + wr * 64 + fr; const int col0 = u.pn * BM + wc * 32 + 8 * fq;
#pragma unroll
        for (int ai = 0; ai < 2; ++ai)
#pragma unroll
            for (int m = 0; m < 4; ++m) { bf16_t* rowp = O + (size_t)(row0 + ai * HALF + m * 16) * ldc + col0;
#pragma unroll
                for (int bj = 0; bj < 2; ++bj) { const f32x4 v0 = acc[ai][bj][m][0], v1 = acc[ai][bj][m][1];
                    u32x4 w; w.x = cvt_pk_bf16(v0[0], v0[1]); w.y = cvt_pk_bf16(v0[2], v0[3]); w.z = cvt_pk_bf16(v1[0], v1[1]); w.w = cvt_pk_bf16(v1[2], v1[3]);
                    *(u32x4*)(rowp + bj * HALF) = w; } }
    }
};
struct EpiRes {
    static constexpr bool PERM = false, AFTER_DRAIN = false;
    const float* xres; float* out; const float* gt;
    __device__ __forceinline__ void operator()(const f32x4 (&acc)[2][2][4][2], const Unit& u, int wr, int wc, int fr, int fq) const {
        const int row0 = u.pm * BM + wr * 64 + fr; const int col0 = u.pn * BM + wc * 32 + 4 * fq; const float* g = gt + (size_t)(u.pm >> 3) * 6144 + col0;
        f32x4 gv[2][2];
#pragma unroll
        for (int bj = 0; bj < 2; ++bj)
#pragma unroll
            for (int n = 0; n < 2; ++n) gv[bj][n] = *(const f32x4*)(g + bj * HALF + n * 16);
#pragma unroll
        for (int ai = 0; ai < 2; ++ai)
#pragma unroll
            for (int m = 0; m < 4; ++m) { const size_t off = (size_t)(row0 + ai * HALF + m * 16) * 1024 + col0;
#pragma unroll
                for (int bj = 0; bj < 2; ++bj)
#pragma unroll
                    for (int n = 0; n < 2; ++n) { const f32x4 xv = *(const f32x4*)(xres + off + bj * HALF + n * 16); *(f32x4*)(out + off + bj * HALF + n * 16) = xv + gv[bj][n] * acc[ai][bj][m][n]; } }
    }
};
struct EpiSwiGLU {
    static constexpr bool PERM = true, AFTER_DRAIN = false;
    bf16_t* H;
    __device__ __forceinline__ void operator()(const f32x4 (&acc)[2][2][4][2], const Unit& u, int wr, int wc, int fr, int fq) const {
        const int row0 = u.pm * BM + wr * 64 + fr; const int hcol0 = u.pn * 128 + wc * 16 + 4 * fq;
#pragma unroll
        for (int ai = 0; ai < 2; ++ai)
#pragma unroll
            for (int m = 0; m < 4; ++m) { bf16_t* rowp = H + (size_t)(row0 + ai * HALF + m * 16) * 512 + hcol0;
#pragma unroll
                for (int bj = 0; bj < 2; ++bj) { const f32x4 a = acc[ai][bj][m][0], b = acc[ai][bj][m][1]; f32x4 o;
#pragma unroll
                    for (int i = 0; i < 4; ++i) o[i] = a[i] * __builtin_amdgcn_rcpf(1.0f + __expf(-a[i])) * b[i];
                    u32x2 w; w.x = cvt_pk_bf16(o[0], o[1]); w.y = cvt_pk_bf16(o[2], o[3]);
                    *(u32x2*)(rowp + bj * 64) = w; } }
    }
};
struct EpiGate {
    static constexpr bool PERM = true, AFTER_DRAIN = false;
    bf16_t* O; const float* rs;
    __device__ __forceinline__ void operator()(const f32x4 (&acc)[2][2][4][2], const Unit& u, int wr, int wc, int fr, int fq) const {
        const int row0 = u.pm * BM + wr * 64 + fr; const int col0 = u.pn * BM + wc * 32 + 8 * fq;
#pragma unroll
        for (int ai = 0; ai < 2; ++ai)
#pragma unroll
            for (int m = 0; m < 4; ++m) { const int row = row0 + ai * HALF + m * 16; const float s = rs[row]; bf16_t* rowp = O + (size_t)row * 1024 + col0;
#pragma unroll
                for (int bj = 0; bj < 2; ++bj) { const f32x4 v0 = acc[ai][bj][m][0] * s, v1 = acc[ai][bj][m][1] * s;
                    u32x4 w; w.x = cvt_pk_bf16(v0[0], v0[1]); w.y = cvt_pk_bf16(v0[2], v0[3]); w.z = cvt_pk_bf16(v1[0], v1[1]); w.w = cvt_pk_bf16(v1[2], v1[3]);
                    *(u32x4*)(rowp + bj * HALF) = w; } }
    }
};
template <class Epi, class Sched, bool ALIGN_EPI = false, bool SP2 = false>
__device__ __forceinline__ void gemm_phase(PG8_LAS unsigned char* lds, const Gemm g, const Sched& S, const Epi& E, const int tid) {
    const int wid = __builtin_amdgcn_readfirstlane(tid >> 6), lane = tid & 63, wr = wid >> 2, wc = wid & 3, fr = lane & 15, fq = lane >> 4;
    const int K = g.K, nt = K / BK;
    unsigned voffA[2], voffB[2];
#pragma unroll
    for (int i = 0; i < 2; ++i) { int R, C; stage_rc(tid * 16 + i * 8192, R, C); const int Rb = Epi::PERM ? ((R & ~31) + perm32(R & 31)) : R;
        voffA[i] = (unsigned)(R * K + C) * 2u; voffB[i] = (unsigned)(Rb * K + C) * 2u; }
    const size_t kstep = (size_t)(BK * 2);
    const size_t hstep = (size_t)HALF * K * 2;
    const size_t tstep = 2 * hstep;
    const unsigned ldsw = (unsigned)wid * 1024u;
    const int aoff = lds_byte(wr * 64 + fr, fq * 8), boff = lds_byte(wc * 32 + fr, fq * 8);
#define PG8_SA(b, h) (((b) * 2 + (h)) * HTB)
#define PG8_SB(b, h) ((4 + (b) * 2 + (h)) * HTB)
#define PG8_STAGE(bufoff, gbase, voff) do { _Pragma("unroll") for (int _i = 0; _i < 2; ++_i) \
        __builtin_amdgcn_global_load_lds((const unsigned*)((const char*)(gbase) + (voff)[_i]), (PG8_LAS unsigned*)(lds + (bufoff) + ldsw + _i * 8192), 16, 0, 0); } while (0)
#define PG8_LDA(dst, b, h) do { _Pragma("unroll") for (int m = 0; m < 4; ++m) _Pragma("unroll") for (int k = 0; k < 2; ++k) dst[m][k] = *(const PG8_LAS bf16x8*)(lds + PG8_SA(b, h) + aoff + m * 2048 + k * 1024); } while (0)
#define PG8_LDB(dst, b, h) do { _Pragma("unroll") for (int n = 0; n < 2; ++n) _Pragma("unroll") for (int k = 0; k < 2; ++k) dst[n][k] = *(const PG8_LAS bf16x8*)(lds + PG8_SB(b, h) + boff + n * 2048 + k * 1024); } while (0)
#define PG8_MMA(ai, bj, At, Bt) do { __builtin_amdgcn_s_setprio(1); _Pragma("unroll") for (int m = 0; m < 4; ++m) _Pragma("unroll") for (int n = 0; n < 2; ++n) _Pragma("unroll") for (int k = 0; k < 2; ++k) \
        acc[ai][bj][m][n] = __builtin_amdgcn_mfma_f32_16x16x32_bf16(Bt[n][k], At[m][k], acc[ai][bj][m][n], 0, 0, 0); __builtin_amdgcn_s_setprio(0); } while (0)
#define PG8_WAIT_V(n) asm volatile("s_waitcnt vmcnt(" #n ")" ::: "memory")
#define PG8_WAIT_L(n) asm volatile("s_waitcnt lgkmcnt(" #n ")" ::: "memory")
#define PG8_BAR __builtin_amdgcn_s_barrier()
#define PG8_SCHED __builtin_amdgcn_sched_barrier(0)
    Unit cur, nxt; int ui = 0;
    if (!S.next(0, cur)) return;
    f32x4 acc[2][2][4][2];
#pragma unroll
    for (int a = 0; a < 2; ++a)
#pragma unroll
        for (int b = 0; b < 2; ++b)
#pragma unroll
            for (int m = 0; m < 4; ++m)
#pragma unroll
                for (int n = 0; n < 2; ++n) acc[a][b][m][n] = (f32x4){0.f, 0.f, 0.f, 0.f};
    bf16x8 At[4][2], B0[2][2], B1[2][2];
    const char* cA = cur.a; const char* cB = cur.b;
    S.a_ready(cur);
    if constexpr (SP2) {
        PG8_STAGE(PG8_SB(0, 0), cB, voffB); PG8_STAGE(PG8_SB(0, 1), cB + hstep, voffB); PG8_STAGE(PG8_SA(0, 0), cA, voffA); PG8_STAGE(PG8_SA(0, 1), cA + hstep, voffA);
        if (wr == 1) PG8_BAR;
        PG8_WAIT_V(2); PG8_BAR;
        PG8_STAGE(PG8_SB(1, 0), cB + kstep, voffB); PG8_STAGE(PG8_SA(1, 0), cA + kstep, voffA); PG8_STAGE(PG8_SB(1, 1), cB + hstep + kstep, voffB);
        PG8_WAIT_V(6); PG8_BAR;
    } else {
        PG8_STAGE(PG8_SB(0, 0), cB, voffB); PG8_STAGE(PG8_SA(0, 0), cA, voffA); PG8_STAGE(PG8_SB(0, 1), cB + hstep, voffB); PG8_STAGE(PG8_SA(0, 1), cA + hstep, voffA);
        if (wr == 1) PG8_BAR;
        PG8_WAIT_V(4); PG8_BAR;
        PG8_STAGE(PG8_SB(1, 0), cB + kstep, voffB); PG8_STAGE(PG8_SA(1, 0), cA + kstep, voffA); PG8_STAGE(PG8_SB(1, 1), cB + hstep + kstep, voffB);
        PG8_WAIT_V(6); PG8_BAR;
    }
    for (;;) {
        const bool has_next = S.next(ui + 1, nxt);
        const char* nA = has_next ? nxt.a : cA; const char* nB = has_next ? nxt.b : cB;
        for (int t = 0; t < nt; t += 2) {
            const bool last = (t == nt - 2);
            const char* a1 = cA + (size_t)(t + 1) * kstep;
            const char* a2 = last ? nA : cA + (size_t)(t + 2) * kstep; const char* b2 = last ? nB : cB + (size_t)(t + 2) * kstep;
            const char* a3 = a2 + kstep; const char* b3 = b2 + kstep;
            if (last && has_next) S.a_ready(nxt);
            if constexpr (SP2) {
            PG8_LDB(B0, 0, 0); PG8_LDB(B1, 0, 1); PG8_SCHED; PG8_LDA(At, 0, 0); PG8_STAGE(PG8_SA(1, 1), a1 + hstep, voffA);
            PG8_WAIT_V(8); PG8_WAIT_L(0); PG8_BAR; PG8_MMA(0, 0, At, B0); PG8_MMA(0, 1, At, B1); PG8_BAR; PG8_SCHED;
            PG8_LDA(At, 0, 1); PG8_STAGE(PG8_SB(0, 0), b2, voffB); PG8_STAGE(PG8_SB(0, 1), b2 + hstep, voffB); PG8_STAGE(PG8_SA(0, 0), a2, voffA);
            PG8_WAIT_V(8); PG8_WAIT_L(0); PG8_BAR; PG8_MMA(1, 0, At, B0); PG8_MMA(1, 1, At, B1); PG8_BAR; PG8_SCHED;
            PG8_LDB(B0, 1, 0); PG8_LDB(B1, 1, 1); PG8_SCHED; PG8_LDA(At, 1, 0); PG8_STAGE(PG8_SA(0, 1), a2 + hstep, voffA);
            PG8_WAIT_V(8); PG8_WAIT_L(0); PG8_BAR; PG8_MMA(0, 0, At, B0); PG8_MMA(0, 1, At, B1); PG8_BAR; PG8_SCHED;
            PG8_LDA(At, 1, 1); PG8_STAGE(PG8_SB(1, 0), b3, voffB); PG8_STAGE(PG8_SB(1, 1), b3 + hstep, voffB); PG8_STAGE(PG8_SA(1, 0), a3, voffA);
            PG8_WAIT_V(8); PG8_WAIT_L(0); PG8_BAR; PG8_MMA(1, 0, At, B0); PG8_MMA(1, 1, At, B1); PG8_BAR; PG8_SCHED;
            } else {
            PG8_LDB(B0, 0, 0); PG8_SCHED; PG8_LDA(At, 0, 0); PG8_STAGE(PG8_SA(1, 1), a1 + hstep, voffA);
            PG8_WAIT_L(8); PG8_BAR; PG8_WAIT_L(0); PG8_MMA(0, 0, At, B0); PG8_BAR; PG8_SCHED;
            PG8_LDB(B1, 0, 1); PG8_STAGE(PG8_SB(0, 0), b2, voffB);
            PG8_BAR; PG8_WAIT_L(0); PG8_MMA(0, 1, At, B1); PG8_BAR;
            PG8_LDA(At, 0, 1); PG8_STAGE(PG8_SA(0, 0), a2, voffA);
            PG8_BAR; PG8_WAIT_L(0); PG8_MMA(1, 0, At, B0); PG8_BAR; PG8_SCHED;
            PG8_STAGE(PG8_SB(0, 1), b2 + hstep, voffB);
            PG8_WAIT_V(6); PG8_BAR; PG8_MMA(1, 1, At, B1); PG8_BAR;
            PG8_LDB(B0, 1, 0); PG8_SCHED; PG8_LDA(At, 1, 0); PG8_STAGE(PG8_SA(0, 1), a2 + hstep, voffA);
            PG8_WAIT_L(8); PG8_BAR; PG8_WAIT_L(0); PG8_MMA(0, 0, At, B0); PG8_BAR; PG8_SCHED;
            PG8_LDB(B1, 1, 1); PG8_STAGE(PG8_SB(1, 0), b3, voffB);
            PG8_BAR; PG8_WAIT_L(0); PG8_MMA(0, 1, At, B1); PG8_BAR;
            PG8_LDA(At, 1, 1); PG8_STAGE(PG8_SA(1, 0), a3, voffA);
            PG8_BAR; PG8_WAIT_L(0); PG8_MMA(1, 0, At, B0); PG8_BAR; PG8_SCHED;
            PG8_STAGE(PG8_SB(1, 1), b3 + hstep, voffB);
            PG8_WAIT_V(6); PG8_BAR; PG8_MMA(1, 1, At, B1); PG8_BAR;
            }
        }
        if constexpr (ALIGN_EPI) { if (wr == 0) PG8_BAR; }
        if constexpr (!Epi::AFTER_DRAIN) { E(acc, cur, wr, wc, fr, fq); S.done(cur); }
        if (!has_next) break;
#pragma unroll
        for (int a = 0; a < 2; ++a)
#pragma unroll
            for (int b = 0; b < 2; ++b)
#pragma unroll
                for (int m = 0; m < 4; ++m)
#pragma unroll
                    for (int n = 0; n < 2; ++n) acc[a][b][m][n] = (f32x4){0.f, 0.f, 0.f, 0.f};
        cur = nxt; cA = nA; cB = nB; ++ui;
        if constexpr (ALIGN_EPI) { if (wr == 1) PG8_BAR; }
    }
    PG8_WAIT_V(0);
    if constexpr (!ALIGN_EPI) { if (wr == 0) PG8_BAR; }
    PG8_BAR;
    if constexpr (Epi::AFTER_DRAIN) { E.fused(acc, cur, wr, wc, fr, fq, lds, wid, lane); S.done(cur); }
#undef PG8_SA
#undef PG8_SB
#undef PG8_STAGE
#undef PG8_LDA
#undef PG8_LDB
#undef PG8_MMA
#undef PG8_WAIT_V
#undef PG8_WAIT_L
#undef PG8_BAR
#undef PG8_SCHED
}
}

#ifndef PH_MASK
#define PH_MASK 0x7fff
#endif
#define PHE(b) ((PH_MASK >> (b)) & 1)
constexpr int DM = 1024, NB = 32, SEQ = 2048, NTOK = NB * SEQ, DEPTH = 2, NWAVES = 8;
constexpr int PW = 3328;
constexpr int PREF = 3244;
constexpr int A_R = 0, A_K = 256, A_V = 512, A_WD = 768, A_AD = 800, A_GD = 832;
constexpr int B_Q = 896, B_K = 1152, B_V = 1408;
constexpr int C_Q = 1664, C_K = 1920, C_V = 2176, C_O = 2432, C_I = 2688, C_F = 2692;
constexpr int D_Q = 2752, D_K = 3008, D_V = 3072, D_QI = 3136, D_KI = 3264, D_WI = 3296;
constexpr int DREF0 = 2696;
constexpr int NEXP = 32, FF = 512;
constexpr int MAXSLOT = NTOK * 2 + NEXP * 256;
constexpr int MAXTILES = MAXSLOT / 256;

constexpr size_t MiB = 1u << 20;
constexpr size_t WS_CTL = 0, CTL_ZERO_BYTES = 1 * MiB;
constexpr size_t WS_MOD = 1 * MiB;
constexpr size_t WS_ROPE = 3 * MiB;
constexpr size_t WS_WIN = 4 * MiB;
constexpr size_t WS_WOUT = 17 * MiB;
constexpr size_t WS_WR = 21 * MiB;
constexpr size_t WS_W13 = 22 * MiB;
constexpr size_t WS_W2 = 150 * MiB;
constexpr size_t WS_ROUTE = 214 * MiB;
constexpr size_t RT_EXPERT = 0, RT_GATE = 512 * 1024, RT_TOKSLOT = 1024 * 1024, RT_SLOTW = 1536 * 1024, RT_CNT = 2304 * 1024, RT_TILE = 2368 * 1024;
constexpr size_t WS_MASK = 218 * MiB;
constexpr size_t WS_XN = 234 * MiB;
constexpr size_t WS_YCAT = 362 * MiB;
constexpr size_t WS_P = 490 * MiB;
constexpr size_t WS_XS = WS_P;
constexpr size_t WS_H = WS_P + 272 * MiB;
constexpr size_t WS_END = 906 * MiB;
static_assert(WS_H + (size_t)MAXSLOT * 512 * 2 <= WS_END && WS_P + (size_t)NTOK * PW * 2 <= WS_END, "ws map");
constexpr int CW_Q = 64;
constexpr int CW_BAR = 4096;

constexpr int LDS_BYTES = 155648;
constexpr int MISC_OFF = 153600;

#define GAS __attribute__((address_space(1)))
#define LAS __attribute__((address_space(3)))
typedef unsigned short bf16;
typedef unsigned v4u __attribute__((ext_vector_type(4)));
typedef float f32x4 __attribute__((ext_vector_type(4)));
typedef short bf16x8 __attribute__((ext_vector_type(8)));
typedef GAS unsigned gu32;
typedef GAS unsigned long long gu64;
#define RLX_AGENT __ATOMIC_RELAXED, __HIP_MEMORY_SCOPE_AGENT
#define LDS_WAIT() asm volatile("s_waitcnt lgkmcnt(0)" ::: "memory")
#define VM_WAIT() asm volatile("s_waitcnt vmcnt(0)" ::: "memory")
__device__ __forceinline__ unsigned long long rt() { return __builtin_amdgcn_s_memrealtime(); }
__device__ __forceinline__ unsigned f2bf(float f) { unsigned u = __builtin_bit_cast(unsigned, f); return (u + 0x7fffu + ((u >> 16) & 1u)) >> 16; }
__device__ __forceinline__ unsigned pk2(float lo, float hi) { return f2bf(lo) | (f2bf(hi) << 16); }

#define XB_TMO      128
#define XB_XCNT(j)  (256  + 64 * (j))
#define XB_XSUB(j)  (1280 + 64 * (j))
#define XB_XGEN(j)  (2304 + 64 * (j))
#define XB_TOP      3328
#define XB_TOPGEN   3392
#define XCD_BAR_WORDS 3456
#define XB_SPIN_CAP (1u << 18)

__device__ __forceinline__ unsigned xb_ld(unsigned* p)              { return __hip_atomic_load(p, __ATOMIC_RELAXED, __HIP_MEMORY_SCOPE_AGENT); }
__device__ __forceinline__ unsigned xb_add(unsigned* p, unsigned v) { return __hip_atomic_fetch_add(p, v, __ATOMIC_RELAXED, __HIP_MEMORY_SCOPE_AGENT); }
__device__ __forceinline__ unsigned xb_xcc_id() { return (unsigned)__builtin_amdgcn_s_getreg((3 << 11) | 20) & 0xFu; }
#define XB_SPIN(cond, bar) do { unsigned _sp = 0; while (cond) { __builtin_amdgcn_s_sleep(1); \
    if ((++_sp & 255u) == 0u) { if (xb_ld(&(bar)[XB_TMO])) break; if (_sp > XB_SPIN_CAP) { atomicAdd(&(bar)[XB_TMO], 1u); break; } } } } while (0)

struct XcdBarrier {
    unsigned* bar; unsigned x;
    volatile LAS unsigned* st;
};

__device__ __forceinline__ XcdBarrier xcd_barrier_post(unsigned* bar, volatile LAS unsigned* st) {
    XcdBarrier b; b.bar = bar; b.x = xb_xcc_id(); b.st = st;
    if (threadIdx.x == 0) (void)xb_add(&bar[XB_XCNT(b.x)], 1u);
    return b;
}
__device__ __forceinline__ void xcd_barrier_complete(unsigned* bar, unsigned x, unsigned& nloc, unsigned& nx) {
    const unsigned G = gridDim.x * gridDim.y * gridDim.z;
    unsigned sum, cnt, mine, sp = 0u;
    for (;;) {
        sum = 0u; cnt = 0u; mine = 0u;
#pragma unroll
        for (unsigned j = 0; j < 16; ++j) { const unsigned c = xb_ld(&bar[XB_XCNT(j)]); sum += c; cnt += (c > 0u) ? 1u : 0u; mine = (j == x) ? c : mine; }
        if (sum == G) break;
        __builtin_amdgcn_s_sleep(1);
        if ((++sp & 255u) == 0u) { if (xb_ld(&bar[XB_TMO])) break; if (sp > XB_SPIN_CAP) { atomicAdd(&bar[XB_TMO], 1u); break; } }
    }
    nloc = mine > 0u ? mine : 1u; nx = cnt > 0u ? cnt : 1u;
}

__device__ __forceinline__ void xcd_barrier(const XcdBarrier& b) {
    asm volatile("s_waitcnt vmcnt(0)" ::: "memory");
    __syncthreads();
    if (threadIdx.x == 0) {
        unsigned* bar = b.bar;
        __builtin_amdgcn_s_waitcnt(0);
        unsigned nloc = b.st[0], nx = b.st[1];
        if (nloc == 0u) { xcd_barrier_complete(bar, b.x, nloc, nx); b.st[0] = nloc; b.st[1] = nx; }
        const unsigned old = xb_add(&bar[XB_XSUB(b.x)], 1u);
        const unsigned gen = old / nloc;
        if (old + 1u == (gen + 1u) * nloc) {
            __builtin_amdgcn_fence(__ATOMIC_RELEASE, "agent");
            asm volatile("s_waitcnt vmcnt(0)" ::: "memory");
            const unsigned og = xb_add(&bar[XB_TOP], 1u);
            const unsigned tg = og / nx;
            if (og + 1u == (tg + 1u) * nx) xb_add(&bar[XB_TOPGEN], 1u);
            else XB_SPIN(xb_ld(&bar[XB_TOPGEN]) == tg, bar);
            __builtin_amdgcn_fence(__ATOMIC_ACQUIRE, "agent");
            xb_add(&bar[XB_XGEN(b.x)], 1u);
            asm volatile("s_waitcnt vmcnt(0)" ::: "memory");
        } else {
            XB_SPIN(xb_ld(&bar[XB_XGEN(b.x)]) == gen, bar);
            __builtin_amdgcn_fence(__ATOMIC_ACQUIRE, "agent");
            asm volatile("s_waitcnt vmcnt(0)" ::: "memory");
        }
    }
    __syncthreads();
}

struct Args { const float* in[35]; float* out; unsigned char* ws; int ph_lo, ph_hi; };
typedef float f32x16 __attribute__((ext_vector_type(16)));
typedef unsigned u32x2v __attribute__((ext_vector_type(2)));
struct Frame {
    unsigned char* lds;
    gu32* ctl;
    int tid, lane, wave, vcu, G, bid;
    const Args* A;
    float* out; unsigned char* ws;
};
enum { I_X = 0, I_C, I_ADAW, I_ADAB, I_N1G, I_N2G, I_WIN, I_MU, I_W0, I_W2, I_A0, I_A2, I_G2, I_KK, I_KA, I_RK, I_LNG, I_LNB, I_SBG, I_CONVW, I_CONVB, I_IGB, I_FGB, I_MLG,
       I_QNG, I_KNG, I_DOG, I_WOUT, I_WG, I_BG, I_WE, I_BE, I_MW1, I_MW3, I_MW2 };

__device__ __forceinline__ float bf2f(unsigned short u) { return __uint_as_float(((unsigned)u) << 16); }
__device__ __forceinline__ float bflo(unsigned u) { return __uint_as_float(u << 16); }
__device__ __forceinline__ float bfhi(unsigned u) { return __uint_as_float(u & 0xffff0000u); }
__device__ __forceinline__ float sigmoidf_(float x) { return __builtin_amdgcn_rcpf(1.0f + __expf(-x)); }
__device__ __forceinline__ float softplusf_(float x) { return fmaxf(x, 0.f) + __logf(1.0f + __expf(-fabsf(x))); }
__device__ __forceinline__ float wave_sum(float v) {
#pragma unroll
    for (int o = 1; o < 64; o <<= 1) v += __shfl_xor(v, o);
    return v;
}
__device__ __forceinline__ float sum16(float v) { v += __shfl_xor(v, 1); v += __shfl_xor(v, 2); v += __shfl_xor(v, 4); v += __shfl_xor(v, 8); return v; }
__device__ __forceinline__ float sum8(float v) { v += __shfl_xor(v, 1); v += __shfl_xor(v, 2); v += __shfl_xor(v, 4); return v; }

__device__ __forceinline__ int rowmap(int mode, int n) {
    if (mode == 1) return n < DREF0 ? n : n + (D_Q - DREF0);
    if (mode == 2) return 8 * (n >> 2) + (n & 3);
    if (mode == 3) return 8 * (n >> 2) + 4 + (n & 3);
    return n;
}
__device__ __forceinline__ void tr_item(const float* W, int K, int N, bf16* WT, int mode, float* scr, int kb, int nb, int lane) {
    const int k0 = 64 * kb, n0 = 32 * nb;
    const int nn = n0 + (lane & 31);
#pragma unroll 8
    for (int i = 0; i < 32; ++i) { const int kk = 2 * i + (lane >> 5); scr[kk * 33 + (lane & 31)] = (nn < N) ? W[(size_t)(k0 + kk) * N + nn] : 0.f; }
    LDS_WAIT(); asm volatile("" ::: "memory");
    const int c = lane & 7;
#pragma unroll
    for (int j = 0; j < 4; ++j) { const int nl = (lane >> 3) + 8 * j; const int n = n0 + nl; const float* s = scr + (8 * c) * 33 + nl;
        v4u o; o.x = pk2(s[0 * 33], s[1 * 33]); o.y = pk2(s[2 * 33], s[3 * 33]); o.z = pk2(s[4 * 33], s[5 * 33]); o.w = pk2(s[6 * 33], s[7 * 33]);
        if (n < N) *(v4u*)(WT + (size_t)rowmap(mode, n) * K + k0 + 8 * c) = o; }
    LDS_WAIT(); asm volatile("" ::: "memory");
}
__device__ __forceinline__ void p0_prologue(Frame& F) {
    unsigned char* ws = F.ws;
    if (F.bid < 192) {
        float* ca = (float*)F.lds;
        const float* c = F.A->in[I_C];
        for (int idx = F.tid; idx < 32768; idx += 512) { const int b = idx & 31, k = idx >> 5; const float cv = c[b * 1024 + k]; ca[idx] = cv * sigmoidf_(cv); }
        __syncthreads();
        const int l = F.bid / 96, cb = F.bid % 96; const int col = cb * 64 + (F.tid & 63), bg = F.tid >> 6;
        const float* W = F.A->in[I_ADAW] + (size_t)l * 1024 * 6144 + col;
        f32x4 acc = {0.f, 0.f, 0.f, 0.f};
#pragma unroll 8
        for (int k = 0; k < 1024; ++k) { const float w = W[(size_t)k * 6144]; const f32x4 cv = *(const f32x4*)(ca + k * 32 + 4 * bg); acc += w * cv; }
        const float bb = F.A->in[I_ADAB][l * 6144 + col];
        float* MOD = (float*)(ws + WS_MOD) + (size_t)l * 32 * 6144;
#pragma unroll
        for (int i = 0; i < 4; ++i) MOD[(size_t)(4 * bg + i) * 6144 + col] = acc[i] + bb;
        __syncthreads();
    }
    const int gt = F.bid * 512 + F.tid, NGT = F.G * 512;
    { float* rope = (float*)(ws + WS_ROPE);
      for (int idx = gt; idx < 2048 * 32; idx += NGT) { const int pos = idx >> 5, i = idx & 31; const float inv = powf(10000.0f, -(float)i / 32.0f); const float ang = (float)pos * inv; float s, c; sincosf(ang, &s, &c); rope[2 * idx] = c; rope[2 * idx + 1] = s; } }
    { bf16* wr = (bf16*)(ws + WS_WR);
      for (int idx = gt; idx < 2 * 36 * 1024; idx += NGT) { const int l = idx / (36 * 1024), r = idx % (36 * 1024), o = r >> 10, k = r & 1023;
          const float v = (o < 4) ? F.A->in[I_WG][((size_t)l * 1024 + k) * 4 + o] : F.A->in[I_WE][((size_t)l * 1024 + k) * 32 + (o - 4)]; wr[idx] = (bf16)f2bf(v); } }
    { bf16* win = (bf16*)(ws + WS_WIN);
      for (int idx = gt; idx < 2 * 84 * 128; idx += NGT) { const int l = idx / (84 * 128), r = idx % (84 * 128), rr = r >> 7, ch = r & 127; const int row = rr < 56 ? DREF0 + rr : 3300 + (rr - 56);
          *(v4u*)(win + ((size_t)l * PW + row) * 1024 + ch * 8) = (v4u){0u, 0u, 0u, 0u}; } }
    float* scr = (float*)(F.lds + F.wave * 16384);
    const int gw = F.vcu * NWAVES + F.wave, NGW = F.G * NWAVES;
    constexpr int I_IN = 16 * 102, I_OUT = 16 * 32, I_E = 256;
    constexpr int N_IN = 2 * I_IN, N_OUT = 2 * I_OUT, N_E = 64 * I_E;
    constexpr int NITEMS = N_IN + N_OUT + 3 * N_E;
    for (int it = gw; it < NITEMS; it += NGW) {
        int r = it;
        if (r < N_IN) { const int l = r / I_IN, q = r % I_IN; tr_item(F.A->in[I_WIN] + (size_t)l * 1024 * PREF, 1024, PREF, (bf16*)(ws + WS_WIN) + (size_t)l * PW * 1024, 1, scr, q / 102, q % 102, F.lane); continue; } r -= N_IN;
        if (r < N_OUT) { const int l = r / I_OUT, q = r % I_OUT; tr_item(F.A->in[I_WOUT] + (size_t)l * 1024 * 1024, 1024, 1024, (bf16*)(ws + WS_WOUT) + (size_t)l * 1024 * 1024, 0, scr, q / 32, q % 32, F.lane); continue; } r -= N_OUT;
        if (r < N_E) { const int le = r / I_E, q = r % I_E; tr_item(F.A->in[I_MW1] + (size_t)le * 1024 * 512, 1024, 512, (bf16*)(ws + WS_W13) + (size_t)le * 1024 * 1024, 2, scr, q / 16, q % 16, F.lane); continue; } r -= N_E;
        if (r < N_E) { const int le = r / I_E, q = r % I_E; tr_item(F.A->in[I_MW3] + (size_t)le * 1024 * 512, 1024, 512, (bf16*)(ws + WS_W13) + (size_t)le * 1024 * 1024, 3, scr, q / 16, q % 16, F.lane); continue; } r -= N_E;
        { const int le = r / I_E, q = r % I_E; tr_item(F.A->in[I_MW2] + (size_t)le * 512 * 1024, 512, 1024, (bf16*)(ws + WS_W2) + (size_t)le * 1024 * 512, 0, scr, q / 32, q % 32, F.lane); }
    }
}

__device__ __forceinline__ void norm_rows(Frame& F, const float* xsrc, int l, int which  ) {
    const int gw = F.bid * NWAVES + F.wave; const int m0 = gw * 32, b = m0 >> 11;
    const float* g = (which ? F.A->in[I_N2G] : F.A->in[I_N1G]) + l * 1024;
    const float* MOD = (const float*)(F.ws + WS_MOD) + ((size_t)l * 32 + b) * 6144 + which * 3072;
    f32x4 mul[4], add[4];
#pragma unroll
    for (int j = 0; j < 4; ++j) { const int e = 4 * (F.lane + 64 * j); const f32x4 gv = *(const f32x4*)(g + e), sc = *(const f32x4*)(MOD + 1024 + e); mul[j] = gv * (1.0f + sc); add[j] = *(const f32x4*)(MOD + e); }
    bf16* XN = (bf16*)(F.ws + WS_XN);
    for (int r = 0; r < 32; ++r) {
        const size_t m = (size_t)(m0 + r);
        const f32x4* xr = (const f32x4*)(xsrc + m * 1024) + F.lane;
        f32x4 v[4]; float s = 0.f;
#pragma unroll
        for (int j = 0; j < 4; ++j) { v[j] = xr[64 * j]; s += (v[j].x * v[j].x + v[j].y * v[j].y) + (v[j].z * v[j].z + v[j].w * v[j].w); }
        const float rs = rsqrtf(wave_sum(s) * (1.0f / 1024.0f) + 1e-6f);
        unsigned long long* o8 = (unsigned long long*)(XN + m * 1024) + F.lane;
#pragma unroll
        for (int j = 0; j < 4; ++j) { const f32x4 h = v[j] * rs * mul[j] + add[j]; o8[64 * j] = (unsigned long long)pk2(h.x, h.y) | ((unsigned long long)pk2(h.z, h.w) << 32); }
    }
}

__device__ __forceinline__ void norm2_route(Frame& F, int l) {
    unsigned char* ws = F.ws;
    unsigned* wrl = (unsigned*)F.lds;
    int* hist = (int*)(F.lds + 73728);
    { const v4u* src = (const v4u*)((const bf16*)(ws + WS_WR) + (size_t)l * 36 * 1024); v4u* dst = (v4u*)F.lds;
      for (int i = F.tid; i < 36 * 1024 * 2 / 16; i += 512) dst[i] = src[i];
      if (F.tid < 32) hist[F.tid] = 0; }
    __syncthreads();
    const int gw = F.bid * NWAVES + F.wave; const int m0 = gw * 32, b = m0 >> 11;
    const float* g = F.A->in[I_N2G] + l * 1024;
    const float* MOD = (const float*)(ws + WS_MOD) + ((size_t)l * 32 + b) * 6144 + 3072;
    f32x4 mul[4], add[4];
#pragma unroll
    for (int j = 0; j < 4; ++j) { const int e = 4 * (F.lane + 64 * j); const f32x4 gv = *(const f32x4*)(g + e), sc = *(const f32x4*)(MOD + 1024 + e); mul[j] = gv * (1.0f + sc); add[j] = *(const f32x4*)(MOD + e); }
    bf16* XN = (bf16*)(ws + WS_XN);
    int* EXPERT = (int*)(ws + WS_ROUTE + RT_EXPERT); float* GATE = (float*)(ws + WS_ROUTE + RT_GATE);
    const float* bgp = F.A->in[I_BG] + l * 4; const float* bep = F.A->in[I_BE] + l * 32;
    const float* xsrc = F.out;
    for (int r = 0; r < 32; ++r) {
        const size_t m = (size_t)(m0 + r);
        const f32x4* xr = (const f32x4*)(xsrc + m * 1024) + F.lane;
        f32x4 v[4]; float s = 0.f;
#pragma unroll
        for (int j = 0; j < 4; ++j) { v[j] = xr[64 * j]; s += (v[j].x * v[j].x + v[j].y * v[j].y) + (v[j].z * v[j].z + v[j].w * v[j].w); }
        const float rs = rsqrtf(wave_sum(s) * (1.0f / 1024.0f) + 1e-6f);
        unsigned long long* o8 = (unsigned long long*)(XN + m * 1024) + F.lane;
#pragma unroll
        for (int j = 0; j < 4; ++j) { v[j] = v[j] * rs * mul[j] + add[j]; o8[64 * j] = (unsigned long long)pk2(v[j].x, v[j].y) | ((unsigned long long)pk2(v[j].z, v[j].w) << 32); }
        float lg[36];
#pragma unroll
        for (int o = 0; o < 36; ++o) { float a = 0.f;
#pragma unroll
            for (int j = 0; j < 4; ++j) { const u32x2v w = *(const u32x2v*)(wrl + o * 512 + 2 * (F.lane + 64 * j)); a += v[j].x * bflo(w.x) + v[j].y * bfhi(w.x) + v[j].z * bflo(w.y) + v[j].w * bfhi(w.y); }
            lg[o] = wave_sum(a); }
        float gl[4]; int gi = 0;
#pragma unroll
        for (int i = 0; i < 4; ++i) gl[i] = lg[i] + bgp[i];
        float gmax = gl[0];
#pragma unroll
        for (int i = 1; i < 4; ++i) if (gl[i] > gmax) { gmax = gl[i]; gi = i; }
        float gsum = 0.f;
#pragma unroll
        for (int i = 0; i < 4; ++i) gsum += __expf(gl[i] - gmax);
        const float gp = 1.0f / gsum;
        float el[8];
#pragma unroll
        for (int i = 0; i < 8; ++i) { float x0 = lg[4 + i] + bep[i], x1 = lg[12 + i] + bep[8 + i], x2 = lg[20 + i] + bep[16 + i], x3 = lg[28 + i] + bep[24 + i]; el[i] = gi == 0 ? x0 : gi == 1 ? x1 : gi == 2 ? x2 : x3; }
        int e1 = 0; float l1 = el[0];
#pragma unroll
        for (int i = 1; i < 8; ++i) if (el[i] > l1) { l1 = el[i]; e1 = i; }
        int e2 = -1; float l2 = -INFINITY;
#pragma unroll
        for (int i = 0; i < 8; ++i) if (i != e1 && el[i] > l2) { l2 = el[i]; e2 = i; }
        const float t2 = __expf(l2 - l1); const float w1 = gp / (1.0f + t2), w2 = gp * t2 / (1.0f + t2);
        if (F.lane == 0) { EXPERT[2 * m] = gi * 8 + e1; EXPERT[2 * m + 1] = gi * 8 + e2; GATE[2 * m] = w1; GATE[2 * m + 1] = w2; atomicAdd(&hist[gi * 8 + e1], 1); atomicAdd(&hist[gi * 8 + e2], 1); }
    }
    __syncthreads();
    if (F.tid < 32) ((int*)(ws + WS_ROUTE + RT_CNT))[F.bid * 32 + F.tid] = hist[F.tid];
    __syncthreads();
}

__device__ __forceinline__ void slot_gather(Frame& F) {
    unsigned char* ws = F.ws;
    int* L = (int*)F.lds; int* partAll = L, *partBef = L + 512, *tot = L + 1024, *bef = L + 1056, *base = L + 1088, *cursor = L + 1120, *slotL = L + 1152;
    const int* CNT = (const int*)(ws + WS_ROUTE + RT_CNT);
    { const int e = F.tid & 31, part = F.tid >> 5; int sa = 0, sb = 0;
      for (int w = part * 16; w < part * 16 + 16; ++w) { const int c = CNT[w * 32 + e]; sa += c; if (w < F.bid) sb += c; }
      partAll[part * 32 + e] = sa; partBef[part * 32 + e] = sb; }
    __syncthreads();
    if (F.tid < 32) { int sa = 0, sb = 0; for (int p = 0; p < 16; ++p) { sa += partAll[p * 32 + F.tid]; sb += partBef[p * 32 + F.tid]; } tot[F.tid] = sa; bef[F.tid] = sb; cursor[F.tid] = 0; }
    __syncthreads();
    if (F.tid == 0) { int ps = 0; int* TILE = (int*)(ws + WS_ROUTE + RT_TILE); int ti = 0;
        for (int e = 0; e < 32; ++e) { base[e] = ps + bef[e]; const int nt = (tot[e] + 255) >> 8; if (F.bid == 0) for (int t = 0; t < nt; ++t) TILE[1 + ti + t] = e; ti += nt; ps += nt * 256; }
        if (F.bid == 0) TILE[0] = ti; }
    __syncthreads();
    const int* EXPERT = (const int*)(ws + WS_ROUTE + RT_EXPERT); const float* GATE = (const float*)(ws + WS_ROUTE + RT_GATE);
    int* TOKSLOT = (int*)(ws + WS_ROUTE + RT_TOKSLOT); float* SLOTW = (float*)(ws + WS_ROUTE + RT_SLOTW);
    { const int a = F.tid; const size_t idx = (size_t)F.bid * 512 + a; const int e = EXPERT[idx]; const int rank = atomicAdd(&cursor[e], 1); const int slot = base[e] + rank;
      SLOTW[slot] = GATE[idx]; TOKSLOT[idx] = slot; slotL[a] = slot; }
    __syncthreads();
    const bf16* XN = (const bf16*)(ws + WS_XN); bf16* XS = (bf16*)(ws + WS_XS);
    for (int i = 0; i < 64; ++i) { const int a = F.wave * 64 + i; const int slot = slotL[a]; const size_t tok = (size_t)F.bid * 256 + (a >> 1);
        const v4u* src = (const v4u*)(XN + tok * 1024); v4u* dst = (v4u*)(XS + (size_t)slot * 1024);
        dst[F.lane] = src[F.lane]; dst[64 + F.lane] = src[64 + F.lane]; }
    __syncthreads();
}

__device__ __forceinline__ void combine_rows(Frame& F, int l, bool next_norm) {
    unsigned char* ws = F.ws;
    const int gw = F.bid * NWAVES + F.wave; const int m0 = gw * 32, b = m0 >> 11;
    const float* MODl = (const float*)(ws + WS_MOD) + ((size_t)l * 32 + b) * 6144;
    f32x4 gt2[4], mul[4], add[4];
#pragma unroll
    for (int j = 0; j < 4; ++j) { const int e = 4 * (F.lane + 64 * j); gt2[j] = *(const f32x4*)(MODl + 5120 + e); mul[j] = gt2[j]; add[j] = gt2[j]; }
    if (next_norm) { const float* g = F.A->in[I_N1G] + (l + 1) * 1024; const float* MODn = (const float*)(ws + WS_MOD) + ((size_t)(l + 1) * 32 + b) * 6144;
#pragma unroll
        for (int j = 0; j < 4; ++j) { const int e = 4 * (F.lane + 64 * j); const f32x4 gv = *(const f32x4*)(g + e), sc = *(const f32x4*)(MODn + 1024 + e); mul[j] = gv * (1.0f + sc); add[j] = *(const f32x4*)(MODn + e); } }
    const int* TOKSLOT = (const int*)(ws + WS_ROUTE + RT_TOKSLOT); const bf16* YS = (const bf16*)(ws + WS_XS); bf16* XN = (bf16*)(ws + WS_XN);
    for (int r = 0; r < 32; ++r) {
        const size_t m = (size_t)(m0 + r);
        const int s0 = TOKSLOT[2 * m], s1 = TOKSLOT[2 * m + 1];
        f32x4* xr = (f32x4*)(F.out + m * 1024) + F.lane;
        const u32x2v* y0 = (const u32x2v*)(YS + (size_t)s0 * 1024) + F.lane; const u32x2v* y1 = (const u32x2v*)(YS + (size_t)s1 * 1024) + F.lane;
        f32x4 v[4]; float s = 0.f;
#pragma unroll
        for (int j = 0; j < 4; ++j) { const f32x4 x = xr[64 * j]; const u32x2v a = y0[64 * j], c = y1[64 * j];
            f32x4 y; y.x = bflo(a.x) + bflo(c.x); y.y = bfhi(a.x) + bfhi(c.x); y.z = bflo(a.y) + bflo(c.y); y.w = bfhi(a.y) + bfhi(c.y);
            v[j] = x + gt2[j] * y; xr[64 * j] = v[j]; s += (v[j].x * v[j].x + v[j].y * v[j].y) + (v[j].z * v[j].z + v[j].w * v[j].w); }
        if (next_norm) {
            const float rs = rsqrtf(wave_sum(s) * (1.0f / 1024.0f) + 1e-6f);
            unsigned long long* o8 = (unsigned long long*)(XN + m * 1024) + F.lane;
#pragma unroll
            for (int j = 0; j < 4; ++j) { const f32x4 h = v[j] * rs * mul[j] + add[j]; o8[64 * j] = (unsigned long long)pk2(h.x, h.y) | ((unsigned long long)pk2(h.z, h.w) << 32); }
        }
    }
}

__device__ __forceinline__ void dsa_prep(Frame& F, int l) {
    bf16* P = (bf16*)(F.ws + WS_P); const float* rope = (const float*)(F.ws + WS_ROPE);
    const float* gq = F.A->in[I_QNG] + l * 64; const float* gk = F.A->in[I_KNG] + l * 64;
    const int gw = F.bid * NWAVES + F.wave; const int hh = F.lane >> 4, i = F.lane & 15;
    const float gq0 = gq[i], gq1 = gq[i + 16], gq2 = gq[i + 32], gq3 = gq[i + 48];
    const float gk0 = gk[i], gk1 = gk[i + 16], gk2 = gk[i + 32], gk3 = gk[i + 48];
    for (int r = 0; r < 32; ++r) {
        const size_t m = (size_t)gw * 32 + r; const int pos = (int)(m & 2047);
        bf16* row = P + m * PW; const float* rp = rope + (size_t)pos * 64;
        const float c0 = rp[2 * i], s0 = rp[2 * i + 1], c1 = rp[2 * (i + 16)], s1 = rp[2 * (i + 16) + 1];
        { bf16* q = row + D_Q + hh * 64;
          const float x0 = bf2f(q[i]), x1 = bf2f(q[i + 16]), x2 = bf2f(q[i + 32]), x3 = bf2f(q[i + 48]);
          const float rs = rsqrtf(sum16(x0 * x0 + x1 * x1 + x2 * x2 + x3 * x3) * (1.0f / 64.0f) + 1e-6f);
          const float a0 = x0 * rs * gq0, a1 = x1 * rs * gq1, a2 = x2 * rs * gq2, a3 = x3 * rs * gq3;
          q[i] = (bf16)f2bf(a0 * c0 - a2 * s0); q[i + 32] = (bf16)f2bf(a2 * c0 + a0 * s0);
          q[i + 16] = (bf16)f2bf(a1 * c1 - a3 * s1); q[i + 48] = (bf16)f2bf(a3 * c1 + a1 * s1); }
        { bf16* k = row + D_K;
          const float x0 = bf2f(k[i]), x1 = bf2f(k[i + 16]), x2 = bf2f(k[i + 32]), x3 = bf2f(k[i + 48]);
          const float rs = rsqrtf(sum16(x0 * x0 + x1 * x1 + x2 * x2 + x3 * x3) * (1.0f / 64.0f) + 1e-6f);
          const float a0 = x0 * rs * gk0, a1 = x1 * rs * gk1, a2 = x2 * rs * gk2, a3 = x3 * rs * gk3;
          const unsigned short o0 = (bf16)f2bf(a0 * c0 - a2 * s0), o2 = (bf16)f2bf(a2 * c0 + a0 * s0), o1 = (bf16)f2bf(a1 * c1 - a3 * s1), o3 = (bf16)f2bf(a3 * c1 + a1 * s1);
          asm volatile("" ::: "memory");
          if (hh == 0) { k[i] = o0; k[i + 32] = o2; k[i + 16] = o1; k[i + 48] = o3; } }
        const float ci = rp[4 * i], si = rp[4 * i + 1];
        { bf16* qi = row + D_QI + hh * 32; const float x1 = bf2f(qi[i]), x2 = bf2f(qi[i + 16]); qi[i] = (bf16)f2bf(x1 * ci - x2 * si); qi[i + 16] = (bf16)f2bf(x2 * ci + x1 * si); }
        { bf16* ki = row + D_KI; const float x1 = bf2f(ki[i]), x2 = bf2f(ki[i + 16]); const unsigned short o1 = (bf16)f2bf(x1 * ci - x2 * si), o2 = (bf16)f2bf(x2 * ci + x1 * si);
          asm volatile("" ::: "memory");
          if (hh == 0) { ki[i] = o1; ki[i + 16] = o2; } }
        if (F.lane < 4) { bf16* wi = row + D_WI; wi[F.lane] = (bf16)f2bf(bf2f(wi[F.lane]) * 0.08838834764831845f); }
    }
}

__device__ __forceinline__ void rwkv_item(Frame& F, int l, int b, int h) {
    const bf16* P = (const bf16*)(F.ws + WS_P); bf16* YC = (bf16*)(F.ws + WS_YCAT);
    float* RAW = (float*)F.lds;
    float* W2H = RAW + 32 * 320;
    float* A2H = W2H + 32 * 64;
    float* G2H = A2H + 32 * 64;
    float* VEC = G2H + 64 * 64;
    float* YS = VEC + 32 * 7 * 64;
    float* BON = YS + 32 * 64;
    float* PAR = BON + 32;
    const int tid = F.tid;
    const float* mu = F.A->in[I_MU] + l * 896;
    for (int i = tid; i < 32 * 64; i += 512) { const int j = i >> 6, c = i & 63; W2H[i] = F.A->in[I_W2][((size_t)l * 32 + j) * 256 + h * 64 + c]; A2H[i] = F.A->in[I_A2][((size_t)l * 32 + j) * 256 + h * 64 + c]; }
    for (int i = tid; i < 64 * 64; i += 512) { const int j = i >> 6, c = i & 63; G2H[i] = F.A->in[I_G2][((size_t)l * 64 + j) * 256 + h * 64 + c]; }
    if (tid < 448) { const int w = tid >> 6, c = tid & 63; const float* sp = w == 0 ? F.A->in[I_W0] : w == 1 ? F.A->in[I_A0] : w == 2 ? F.A->in[I_KK] : w == 3 ? F.A->in[I_KA] : w == 4 ? F.A->in[I_RK] : w == 5 ? F.A->in[I_LNG] : F.A->in[I_LNB]; PAR[tid] = sp[l * 256 + h * 64 + c]; }
    float S[8];
#pragma unroll
    for (int j = 0; j < 8; ++j) S[j] = 0.f;
    const int row = tid >> 3, seg = tid & 7;
    const int pt = tid >> 4, cg = tid & 15;
    __syncthreads();
    for (int t0 = 0; t0 < SEQ; t0 += 32) {
        for (int i = 0; i < 20; ++i) { const int idx = tid + 512 * i; const int t = idx / 320, col = idx % 320;
            const int pc = col < 64 ? A_R + h * 64 + col : col < 128 ? A_K + h * 64 + (col - 64) : col < 192 ? A_V + h * 64 + (col - 128) : col < 224 ? A_WD + (col - 192) : col < 256 ? A_AD + (col - 224) : A_GD + (col - 256);
            const size_t m = (size_t)b * SEQ + t0 + t; const float cur = bf2f(P[m * PW + pc]); const float prev = (t0 + t > 0) ? bf2f(P[(m - 1) * PW + pc]) : 0.f;
            float v = cur + (prev - cur) * mu[pc];
            if (col >= 192 && col < 224) v = tanhf(v); else if (col >= 256) v = sigmoidf_(v);
            RAW[idx] = v; }
        __syncthreads();
        { const float* rw = RAW + pt * 320; f32x4 wv = *(const f32x4*)(PAR + 4 * cg), av = *(const f32x4*)(PAR + 64 + 4 * cg), gv = {0.f, 0.f, 0.f, 0.f};
#pragma unroll 8
          for (int j = 0; j < 32; ++j) { wv += rw[192 + j] * *(const f32x4*)(W2H + j * 64 + 4 * cg); av += rw[224 + j] * *(const f32x4*)(A2H + j * 64 + 4 * cg); }
#pragma unroll 8
          for (int j = 0; j < 64; ++j) gv += rw[256 + j] * *(const f32x4*)(G2H + j * 64 + 4 * cg);
          const f32x4 rr = *(const f32x4*)(rw + 4 * cg), kk0 = *(const f32x4*)(rw + 64 + 4 * cg), vv = *(const f32x4*)(rw + 128 + 4 * cg);
          const f32x4 k_k = *(const f32x4*)(PAR + 128 + 4 * cg), k_a = *(const f32x4*)(PAR + 192 + 4 * cg), r_k = *(const f32x4*)(PAR + 256 + 4 * cg);
          f32x4 dec, aa, kkr, kmod; float n2 = 0.f, bon = 0.f;
#pragma unroll
          for (int i = 0; i < 4; ++i) { const float w = -softplusf_(-wv[i]) - 0.5f; dec[i] = __expf(-__expf(w)); aa[i] = sigmoidf_(av[i]); kkr[i] = kk0[i] * k_k[i]; n2 += kkr[i] * kkr[i];
              kmod[i] = kk0[i] * (1.0f + (aa[i] - 1.0f) * k_a[i]); bon += rr[i] * kmod[i] * r_k[i]; }
          n2 = sum16(n2); bon = sum16(bon);
          const float inv = 1.0f / fmaxf(sqrtf(n2), 1e-12f);
          float* ve = VEC + pt * 448 + 4 * cg;
          const f32x4 kkn = kkr * inv;
          *(f32x4*)(ve) = dec; *(f32x4*)(ve + 64) = kkn; *(f32x4*)(ve + 128) = kkn * aa; *(f32x4*)(ve + 192) = kmod; *(f32x4*)(ve + 256) = rr; *(f32x4*)(ve + 320) = vv; *(f32x4*)(ve + 384) = gv;
          if (cg == 0) BON[pt] = bon; }
        __syncthreads();
        for (int t = 0; t < 32; ++t) {
            const float* ve = VEC + t * 448 + seg * 8;
            const f32x4 d0 = *(const f32x4*)(ve), d1 = *(const f32x4*)(ve + 4), q0 = *(const f32x4*)(ve + 64), q1 = *(const f32x4*)(ve + 68), b0 = *(const f32x4*)(ve + 128), b1 = *(const f32x4*)(ve + 132),
                        m0 = *(const f32x4*)(ve + 192), m1 = *(const f32x4*)(ve + 196), r0 = *(const f32x4*)(ve + 256), r1 = *(const f32x4*)(ve + 260);
            const float vv = VEC[t * 448 + 320 + row];
            float sa = (S[0] * q0[0] + S[1] * q0[1]) + (S[2] * q0[2] + S[3] * q0[3]) + (S[4] * q1[0] + S[5] * q1[1]) + (S[6] * q1[2] + S[7] * q1[3]);
            sa = -sum8(sa);
#pragma unroll
            for (int j = 0; j < 4; ++j) { S[j] = S[j] * d0[j] + sa * b0[j] + vv * m0[j]; S[4 + j] = S[4 + j] * d1[j] + sa * b1[j] + vv * m1[j]; }
            float y = (S[0] * r0[0] + S[1] * r0[1]) + (S[2] * r0[2] + S[3] * r0[3]) + (S[4] * r1[0] + S[5] * r1[1]) + (S[6] * r1[2] + S[7] * r1[3]);
            y = sum8(y);
            if (seg == 0) YS[t * 64 + row] = y;
        }
        __syncthreads();
        { const f32x4 y = *(const f32x4*)(YS + pt * 64 + 4 * cg); const float mean = sum16((y[0] + y[1]) + (y[2] + y[3])) * (1.0f / 64.0f); const f32x4 d = y - mean;
          const float var = sum16((d[0] * d[0] + d[1] * d[1]) + (d[2] * d[2] + d[3] * d[3])) * (1.0f / 64.0f); const float rs = rsqrtf(var + 64e-5f);
          const f32x4 lg = *(const f32x4*)(PAR + 320 + 4 * cg), lb = *(const f32x4*)(PAR + 384 + 4 * cg);
          const float* ve = VEC + pt * 448 + 4 * cg; const f32x4 vv = *(const f32x4*)(ve + 320), gg = *(const f32x4*)(ve + 384);
          const f32x4 o = (d * rs * lg + lb + BON[pt] * vv) * gg;
          u32x2v w; w.x = pk2(o[0], o[1]); w.y = pk2(o[2], o[3]);
          *(u32x2v*)(YC + ((size_t)b * SEQ + t0 + pt) * 1024 + h * 64 + 4 * cg) = w; }
        __syncthreads();
    }
}

__device__ __forceinline__ void mlstm_item(Frame& F, int l, int b, int h) {
    const bf16* P = (const bf16*)(F.ws + WS_P); bf16* YC = (bf16*)(F.ws + WS_YCAT);
    float* VEC = (float*)F.lds;
    float* HS = VEC + 32 * 256;
    float* GT = HS + 32 * 64;
    float* LIF = GT + 128;
    const int tid = F.tid;
    const float* cw = F.A->in[I_CONVW] + (size_t)l * 4 * 512; const float* cb = F.A->in[I_CONVB] + l * 512;
    const float igb = F.A->in[I_IGB][l * 4 + h], fgb = F.A->in[I_FGB][l * 4 + h];
    float C[8], n[8];
#pragma unroll
    for (int j = 0; j < 8; ++j) { C[j] = 0.f; n[j] = 0.f; }
    float mrun = 0.f;
    const int row = tid >> 3, seg = tid & 7, pt = tid >> 4, cg = tid & 15;
    for (int t0 = 0; t0 < SEQ; t0 += 32) {
        for (int i = 0; i < 8; ++i) { const int idx = tid + 512 * i; const int t = idx >> 7, col = idx & 127, which = col >> 6, c = col & 63;
            const int ch = which * 256 + h * 64 + c; const int pc = (which ? C_K : C_Q) + h * 64 + c; const size_t m = (size_t)b * SEQ + t0 + t;
            float acc = cb[ch];
#pragma unroll
            for (int j = 0; j < 4; ++j) { const int tt = t0 + t - 3 + j; if (tt >= 0) acc += cw[j * 512 + ch] * bf2f(P[(m - 3 + j) * PW + pc]); }
            float v = acc * sigmoidf_(acc); if (which) v *= 0.125f;
            VEC[t * 256 + which * 64 + c] = v;
            const float pv = bf2f(P[m * PW + (which ? C_O : C_V) + h * 64 + c]);
            VEC[t * 256 + 128 + which * 64 + c] = which ? sigmoidf_(pv) : pv; }
        if (tid < 32) { const size_t m = (size_t)b * SEQ + t0 + tid; const float ig = bf2f(P[m * PW + C_I + h]) + igb, fg = bf2f(P[m * PW + C_F + h]) + fgb;
            const float li = 15.0f * tanhf(ig * (1.0f / 15.0f)); const float fc = 15.0f * tanhf(fg * (1.0f / 15.0f)); LIF[2 * tid] = li; LIF[2 * tid + 1] = -softplusf_(-fc); }
        __syncthreads();
        if (tid == 0) { for (int t = 0; t < 32; ++t) { const float li = LIF[2 * t], lf = LIF[2 * t + 1]; const float mn = fmaxf(lf + mrun, li); GT[4 * t] = __expf(lf + mrun - mn); GT[4 * t + 1] = __expf(li - mn); GT[4 * t + 2] = __expf(-mn); mrun = mn; } }
        __syncthreads();
        for (int t = 0; t < 32; ++t) {
            const float* ve = VEC + t * 256 + seg * 8;
            const f32x4 q0 = *(const f32x4*)(ve), q1 = *(const f32x4*)(ve + 4), k0 = *(const f32x4*)(ve + 64), k1 = *(const f32x4*)(ve + 68);
            const float vv = VEC[t * 256 + 128 + row]; const float fs = GT[4 * t], is = GT[4 * t + 1], em = GT[4 * t + 2];
            const float iv = is * vv;
#pragma unroll
            for (int j = 0; j < 4; ++j) { C[j] = fs * C[j] + iv * k0[j]; C[4 + j] = fs * C[4 + j] + iv * k1[j]; n[j] = fs * n[j] + is * k0[j]; n[4 + j] = fs * n[4 + j] + is * k1[j]; }
            float num = (C[0] * q0[0] + C[1] * q0[1]) + (C[2] * q0[2] + C[3] * q0[3]) + (C[4] * q1[0] + C[5] * q1[1]) + (C[6] * q1[2] + C[7] * q1[3]);
            float den = (n[0] * q0[0] + n[1] * q0[1]) + (n[2] * q0[2] + n[3] * q0[3]) + (n[4] * q1[0] + n[5] * q1[1]) + (n[6] * q1[2] + n[7] * q1[3]);
            num = sum8(num); den = sum8(den);
            if (seg == 0) HS[t * 64 + row] = num / fmaxf(fabsf(den), em);
        }
        __syncthreads();
        { const f32x4 hv = *(const f32x4*)(HS + pt * 64 + 4 * cg); const float ms = sum16((hv[0] * hv[0] + hv[1] * hv[1]) + (hv[2] * hv[2] + hv[3] * hv[3])) * (1.0f / 64.0f); const float rs = rsqrtf(ms + 1e-6f);
          const f32x4 g = *(const f32x4*)(F.A->in[I_MLG] + l * 256 + h * 64 + 4 * cg); const f32x4 og = *(const f32x4*)(VEC + pt * 256 + 192 + 4 * cg);
          const f32x4 o = og * (hv * rs * g);
          u32x2v w; w.x = pk2(o[0], o[1]); w.y = pk2(o[2], o[3]);
          *(u32x2v*)(YC + ((size_t)b * SEQ + t0 + pt) * 1024 + 512 + h * 64 + 4 * cg) = w; }
        __syncthreads();
    }
}

__device__ __forceinline__ void sb_item(Frame& F, int l, int b, int h, int qg) {
    const bf16* P = (const bf16*)(F.ws + WS_P); bf16* YC = (bf16*)(F.ws + WS_YCAT);
    const int t0w = __builtin_amdgcn_readfirstlane(qg * 512 + F.wave * 64); const int t = t0w + F.lane;
    const size_t mrow = (size_t)b * SEQ + t;
    float q[64], o[64];
    { const v4u* qp = (const v4u*)(P + mrow * PW + B_Q + h * 64);
#pragma unroll
      for (int i = 0; i < 8; ++i) { const v4u w = qp[i]; q[8 * i] = bflo(w.x) * 0.125f; q[8 * i + 1] = bfhi(w.x) * 0.125f; q[8 * i + 2] = bflo(w.y) * 0.125f; q[8 * i + 3] = bfhi(w.y) * 0.125f;
          q[8 * i + 4] = bflo(w.z) * 0.125f; q[8 * i + 5] = bfhi(w.z) * 0.125f; q[8 * i + 6] = bflo(w.w) * 0.125f; q[8 * i + 7] = bfhi(w.w) * 0.125f; } }
#pragma unroll
    for (int d = 0; d < 64; ++d) o[d] = 0.f;
    float cs = 0.f;
    for (int s = t0w + 62; s >= 0; --s) {
        const bf16* kr = P + ((size_t)b * SEQ + s) * PW + B_K + h * 64; const bf16* vr = P + ((size_t)b * SEQ + s) * PW + B_V + h * 64;
        float z0 = 0.f, z1 = 0.f;
#pragma unroll
        for (int i = 0; i < 8; ++i) { const v4u w = ((const v4u*)kr)[i];
            z0 += q[8 * i] * bflo(w.x) + q[8 * i + 2] * bflo(w.y) + q[8 * i + 4] * bflo(w.z) + q[8 * i + 6] * bflo(w.w);
            z1 += q[8 * i + 1] * bfhi(w.x) + q[8 * i + 3] * bfhi(w.y) + q[8 * i + 5] * bfhi(w.z) + q[8 * i + 7] * bfhi(w.w); }
        const float z = z0 + z1; const bool valid = s < t;
        const float sp = softplusf_(z);
        const float a = valid ? __expf((z - sp) + cs) : 0.f;
#pragma unroll
        for (int i = 0; i < 8; ++i) { const v4u w = ((const v4u*)vr)[i];
            o[8 * i] += a * bflo(w.x); o[8 * i + 1] += a * bfhi(w.x); o[8 * i + 2] += a * bflo(w.y); o[8 * i + 3] += a * bfhi(w.y);
            o[8 * i + 4] += a * bflo(w.z); o[8 * i + 5] += a * bfhi(w.z); o[8 * i + 6] += a * bflo(w.w); o[8 * i + 7] += a * bfhi(w.w); }
        if (valid) cs -= sp;
        if (s < t0w && __all(cs < -120.0f)) break;
    }
    float ms = 0.f;
#pragma unroll
    for (int d = 0; d < 64; ++d) ms += o[d] * o[d];
    const float rs = rsqrtf(ms * (1.0f / 64.0f) + 1e-6f);
    const float* g = F.A->in[I_SBG] + l * 256 + h * 64;
    v4u* op = (v4u*)(YC + mrow * 1024 + 256 + h * 64);
#pragma unroll
    for (int i = 0; i < 8; ++i) { v4u w; w.x = pk2(o[8 * i] * rs * g[8 * i], o[8 * i + 1] * rs * g[8 * i + 1]); w.y = pk2(o[8 * i + 2] * rs * g[8 * i + 2], o[8 * i + 3] * rs * g[8 * i + 3]);
        w.z = pk2(o[8 * i + 4] * rs * g[8 * i + 4], o[8 * i + 5] * rs * g[8 * i + 5]); w.w = pk2(o[8 * i + 6] * rs * g[8 * i + 6], o[8 * i + 7] * rs * g[8 * i + 7]); op[i] = w; }
}

__device__ __forceinline__ unsigned sortable(float v) { const unsigned u = __float_as_uint(v); return u ^ ((u >> 31) ? 0xffffffffu : 0x80000000u); }
__device__ __forceinline__ int wave_isum(int v) {
#pragma unroll
    for (int o = 1; o < 64; o <<= 1) v += __shfl_xor(v, o);
    return v;
}
__device__ __forceinline__ void dsa_item(Frame& F, int l, int b, int qblk) {
    const bf16* P = (const bf16*)(F.ws + WS_P); bf16* YC = (bf16*)(F.ws + WS_YCAT);
    float* SC = (float*)F.lds;
    unsigned* MASKL = (unsigned*)(F.lds + 65536);
    const int lane = F.lane, wave = F.wave, hi = lane >> 5, r32 = lane & 31;
    const size_t brow = (size_t)b * SEQ;
    for (int rd = 0; rd < 16; ++rd) {
        const int tq0 = qblk * 128 + rd * 8; const int nkt = (tq0 + 8 + 31) >> 5;
        { const int hh = r32 >> 3, qq = r32 & 7;
          const bf16* ap = P + (brow + tq0 + qq) * PW + D_QI + hh * 32 + 8 * hi;
          const bf16x8 a0 = *(const bf16x8*)(ap), a1 = *(const bf16x8*)(ap + 16);
          float wv[4][4];
#pragma unroll
          for (int j = 0; j < 4; ++j) { const u32x2v w = *(const u32x2v*)(P + (brow + tq0 + j + 4 * hi) * PW + D_WI); wv[0][j] = bflo(w.x); wv[1][j] = bfhi(w.x); wv[2][j] = bflo(w.y); wv[3][j] = bfhi(w.y); }
          for (int kt = wave; kt < nkt; kt += 8) {
              const int key = kt * 32 + r32; const bf16* bp = P + (brow + key) * PW + D_KI + 8 * hi;
              const bf16x8 b0 = *(const bf16x8*)(bp), b1 = *(const bf16x8*)(bp + 16);
              f32x16 acc = {0.f, 0.f, 0.f, 0.f, 0.f, 0.f, 0.f, 0.f, 0.f, 0.f, 0.f, 0.f, 0.f, 0.f, 0.f, 0.f};
              acc = __builtin_amdgcn_mfma_f32_32x32x16_bf16(a0, b0, acc, 0, 0, 0);
              acc = __builtin_amdgcn_mfma_f32_32x32x16_bf16(a1, b1, acc, 0, 0, 0);
#pragma unroll
              for (int j = 0; j < 4; ++j) { float s = wv[0][j] * fmaxf(acc[j], 0.f); s = fmaf(wv[1][j], fmaxf(acc[4 + j], 0.f), s); s = fmaf(wv[2][j], fmaxf(acc[8 + j], 0.f), s); s = fmaf(wv[3][j], fmaxf(acc[12 + j], 0.f), s);
                  SC[(j + 4 * hi) * 2048 + key] = s; }
          } }
        __syncthreads();
        { const int t = tq0 + wave; const int ql = rd * 8 + wave; unsigned* mrow = MASKL + ql * 64;
          if (t < 256) { const unsigned w = (lane * 32 + 31 <= t) ? 0xffffffffu : (lane * 32 > t) ? 0u : (0xffffffffu >> (31 - (t - lane * 32))); mrow[lane] = w; }
          else {
              unsigned u[32];
#pragma unroll
              for (int i = 0; i < 32; ++i) { const int key = lane + 64 * i; u[i] = (key <= t) ? sortable(SC[wave * 2048 + key]) : 0u; }
              unsigned T = 0u;
              for (int bit = 31; bit >= 0; --bit) { const unsigned cand = T | (1u << bit); int c = 0;
#pragma unroll
                  for (int i = 0; i < 32; ++i) c += (u[i] >= cand) ? 1 : 0;
                  c = wave_isum(c); if (c >= 256) T = cand; }
              int cgt = 0;
#pragma unroll
              for (int i = 0; i < 32; ++i) cgt += (u[i] > T) ? 1 : 0;
              cgt = wave_isum(cgt); const int need = 256 - cgt; int acce = 0; unsigned mylo = 0u;
#pragma unroll
              for (int i = 0; i < 32; ++i) { const bool eq = (u[i] == T); const unsigned long long ball = __ballot(eq);
                  const int pre = __builtin_amdgcn_mbcnt_hi((unsigned)(ball >> 32), __builtin_amdgcn_mbcnt_lo((unsigned)ball, 0u));
                  const bool sel = (u[i] > T) || (eq && (acce + pre < need)); acce += __popcll(ball);
                  const unsigned long long sb = __ballot(sel);
                  if (lane == 2 * i) mylo = (unsigned)sb; if (lane == 2 * i + 1) mylo = (unsigned)(sb >> 32); }
              mrow[lane] = mylo; } }
        __syncthreads();
    }
    { const int ql = wave * 16 + (lane >> 2), hh = lane & 3; const int t = qblk * 128 + ql; const size_t mrow = brow + t;
      const int tmax = __builtin_amdgcn_readfirstlane(qblk * 128 + wave * 16 + 15);
      float gqm = 0.f, gkm = 0.f;
      for (int d = 0; d < 64; ++d) { gqm = fmaxf(gqm, fabsf(F.A->in[I_QNG][l * 64 + d])); gkm = fmaxf(gkm, fabsf(F.A->in[I_KNG][l * 64 + d])); }
      const float cbound = 8.0f * gqm * gkm;
      float q[64], o[64];
      { const v4u* qp = (const v4u*)(P + mrow * PW + D_Q + hh * 64);
#pragma unroll
        for (int i = 0; i < 8; ++i) { const v4u w = qp[i]; q[8 * i] = bflo(w.x) * 0.125f; q[8 * i + 1] = bfhi(w.x) * 0.125f; q[8 * i + 2] = bflo(w.y) * 0.125f; q[8 * i + 3] = bfhi(w.y) * 0.125f;
            q[8 * i + 4] = bflo(w.z) * 0.125f; q[8 * i + 5] = bfhi(w.z) * 0.125f; q[8 * i + 6] = bflo(w.w) * 0.125f; q[8 * i + 7] = bfhi(w.w) * 0.125f; } }
#pragma unroll
      for (int d = 0; d < 64; ++d) o[d] = 0.f;
      float lsum = 0.f; const unsigned* mq = MASKL + ql * 64;
      for (int s = 0; s <= tmax; ++s) {
          const unsigned word = mq[s >> 5]; const bool sel = (word >> (s & 31)) & 1u;
          if (__ballot(sel) == 0ull) continue;
          const bf16* kr = P + (brow + s) * PW + D_K; const bf16* vr = P + (brow + s) * PW + D_V;
          float z0 = 0.f, z1 = 0.f;
#pragma unroll
          for (int i = 0; i < 8; ++i) { const v4u w = ((const v4u*)kr)[i];
              z0 += q[8 * i] * bflo(w.x) + q[8 * i + 2] * bflo(w.y) + q[8 * i + 4] * bflo(w.z) + q[8 * i + 6] * bflo(w.w);
              z1 += q[8 * i + 1] * bfhi(w.x) + q[8 * i + 3] * bfhi(w.y) + q[8 * i + 5] * bfhi(w.z) + q[8 * i + 7] * bfhi(w.w); }
          const float p = sel ? __expf((z0 + z1) - cbound) : 0.f; lsum += p;
#pragma unroll
          for (int i = 0; i < 8; ++i) { const v4u w = ((const v4u*)vr)[i];
              o[8 * i] += p * bflo(w.x); o[8 * i + 1] += p * bfhi(w.x); o[8 * i + 2] += p * bflo(w.y); o[8 * i + 3] += p * bfhi(w.y);
              o[8 * i + 4] += p * bflo(w.z); o[8 * i + 5] += p * bfhi(w.z); o[8 * i + 6] += p * bflo(w.w); o[8 * i + 7] += p * bfhi(w.w); }
      }
      const float il = 1.0f / lsum; float ms = 0.f;
#pragma unroll
      for (int d = 0; d < 64; ++d) { o[d] *= il; ms += o[d] * o[d]; }
      const float rs = rsqrtf(ms * (1.0f / 64.0f) + 1e-6f);
      const float* g = F.A->in[I_DOG] + l * 256 + hh * 64;
      v4u* op = (v4u*)(YC + mrow * 1024 + 768 + hh * 64);
#pragma unroll
      for (int i = 0; i < 8; ++i) { v4u w; w.x = pk2(o[8 * i] * rs * g[8 * i], o[8 * i + 1] * rs * g[8 * i + 1]); w.y = pk2(o[8 * i + 2] * rs * g[8 * i + 2], o[8 * i + 3] * rs * g[8 * i + 3]);
          w.z = pk2(o[8 * i + 4] * rs * g[8 * i + 4], o[8 * i + 5] * rs * g[8 * i + 5]); w.w = pk2(o[8 * i + 6] * rs * g[8 * i + 6], o[8 * i + 7] * rs * g[8 * i + 7]); op[i] = w; } }
    __syncthreads();
}

#define REFRESH() do { int t_ = threadIdx.x; asm volatile("" : "+v"(t_)); F.tid = t_; F.lane = t_ & 63; F.wave = __builtin_amdgcn_readfirstlane(t_ >> 6); } while (0)
__device__ __forceinline__ void mixers_phase(Frame& F, int l) {
    volatile int* qslot = (volatile int*)(F.lds + MISC_OFF + 64);
    for (;;) {
        __syncthreads();
        if (F.tid == 0) *qslot = (int)__hip_atomic_fetch_add((unsigned*)(F.ctl + CW_Q + 64 * l), 1u, __ATOMIC_RELAXED, __HIP_MEMORY_SCOPE_AGENT);
        __syncthreads();
        const int it = __builtin_amdgcn_readfirstlane(*qslot);
        if (it >= 1280) break;
        if (it < 128) { if (PHE(11)) { REFRESH(); rwkv_item(F, l, it >> 2, it & 3); } }
        else if (it < 256) { if (PHE(12)) { REFRESH(); mlstm_item(F, l, (it - 128) >> 2, (it - 128) & 3); } }
        else if (it < 768) { const int j = it - 256; if (PHE(13)) { REFRESH(); dsa_item(F, l, j & 31, 15 - (j >> 5)); } }
        else { const int j = it - 768; if (PHE(14)) { REFRESH(); sb_item(F, l, j >> 4, (j >> 2) & 3, j & 3); } }
    }
}

constexpr int PH_PER_LAYER = 10, N_PHASES = 1 + PH_PER_LAYER * DEPTH;
__global__ void __launch_bounds__(NWAVES * 64, 2) mk_fwd(Args args) {
    extern __shared__ __attribute__((aligned(16))) unsigned char lds[];
    Frame F;
    F.lds = lds;
    F.tid = threadIdx.x; F.lane = F.tid & 63; F.wave = __builtin_amdgcn_readfirstlane(F.tid >> 6);
    F.G = gridDim.x; F.bid = blockIdx.x; { const int bx = blockIdx.x; F.vcu = (F.G % 8 == 0) ? (bx % 8) * (F.G / 8) + bx / 8 : bx; }
    F.ws = args.ws; F.out = args.out; F.ctl = (gu32*)(args.ws + WS_CTL);
    F.A = &args;
    volatile LAS unsigned* MISC = (volatile LAS unsigned*)((LAS unsigned char*)lds + MISC_OFF);
    for (int u = F.tid; u < (LDS_BYTES - MISC_OFF) / 4; u += NWAVES * 64) MISC[u] = 0u;
    __syncthreads();
    const int lo = args.ph_lo, hi = args.ph_hi;
    const bool multi = (hi - lo) > 1;
    XcdBarrier bar; bar.bar = (unsigned*)(F.ctl + CW_BAR); bar.x = 0; bar.st = nullptr;
    if (multi) bar = xcd_barrier_post((unsigned*)(F.ctl + CW_BAR), MISC + 8);
#define IN(k) (lo <= (k) && (k) < hi)
#define PB() do { int t_ = threadIdx.x; asm volatile("" : "+v"(t_)); F.tid = t_; F.lane = t_ & 63; F.wave = __builtin_amdgcn_readfirstlane(t_ >> 6); int b_ = blockIdx.x; asm volatile("" : "+s"(b_)); F.bid = b_; } while (0)
#define SEAM(k) do { if (IN(k) && IN((k) + 1)) xcd_barrier(bar); } while (0)
    LAS unsigned char* ldsl = (LAS unsigned char*)lds;
    bf16* XN = (bf16*)(F.ws + WS_XN); bf16* Pb = (bf16*)(F.ws + WS_P); bf16* YC = (bf16*)(F.ws + WS_YCAT);

    if (PHE(0) && IN(0)) { PB(); p0_prologue(F); }
    SEAM(0);
    for (int l = 0; l < DEPTH; ++l) {
        const int pb = 1 + PH_PER_LAYER * l;
        if (PHE(1) && IN(pb + 0)) { PB(); if (l == 0) norm_rows(F, F.A->in[I_X], 0, 0); }
        if (l == 0) SEAM(pb + 0);
        if (PHE(2) && IN(pb + 1)) { PB();
            pg8::Gemm g{1024}; pg8::DenseOrder S; S.init(XN, (const bf16*)(F.ws + WS_WIN) + (size_t)l * PW * 1024, NTOK, PW, 1024, F.G, F.bid);
            pg8::EpiBf16 E{Pb, PW};
            pg8::gemm_phase<pg8::EpiBf16, pg8::DenseOrder, true, true>(ldsl, g, S, E, F.tid);
        }
        SEAM(pb + 1);
        if (PHE(3) && IN(pb + 2)) { PB(); dsa_prep(F, l); }
        SEAM(pb + 2);
        if (PHE(4) && IN(pb + 3)) { PB(); mixers_phase(F, l); }
        SEAM(pb + 3);
        if (PHE(5) && IN(pb + 4)) { PB();
            pg8::Gemm g{1024}; pg8::DenseOrder S; S.init(YC, (const bf16*)(F.ws + WS_WOUT) + (size_t)l * 1024 * 1024, NTOK, 1024, 1024, F.G, F.bid);
            pg8::EpiRes E{l == 0 ? F.A->in[I_X] : (const float*)F.out, F.out, (const float*)(F.ws + WS_MOD) + (size_t)l * 32 * 6144 + 2048};
            pg8::gemm_phase<pg8::EpiRes, pg8::DenseOrder, true, true>(ldsl, g, S, E, F.tid);
        }
        SEAM(pb + 4);
        if (PHE(6) && IN(pb + 5)) { PB(); norm2_route(F, l); }
        SEAM(pb + 5);
        if (PHE(7) && IN(pb + 6)) { PB(); slot_gather(F); }
        SEAM(pb + 6);
        if (PHE(8) && IN(pb + 7)) { PB();
            const int* TILE = (const int*)(F.ws + WS_ROUTE + RT_TILE); const int ntiles = TILE[0];
            pg8::Gemm g{1024}; pg8::MoeOrder S; S.ntiles = ntiles; S.nN = 4; S.nwg = ntiles * 4; S.G = F.G; S.c = F.bid; S.tile_e = TILE + 1;
            S.A = (const char*)(F.ws + WS_XS); S.W = (const char*)(F.ws + WS_W13) + (size_t)l * 32 * 1024 * 1024 * 2; S.a_tile = (size_t)256 * 1024 * 2; S.w_exp = (size_t)1024 * 1024 * 2; S.w_tile = (size_t)256 * 1024 * 2;
            pg8::EpiSwiGLU E{(bf16*)(F.ws + WS_H)};
            pg8::gemm_phase<pg8::EpiSwiGLU, pg8::MoeOrder, true, true>(ldsl, g, S, E, F.tid);
        }
        SEAM(pb + 7);
        if (PHE(9) && IN(pb + 8)) { PB();
            const int* TILE = (const int*)(F.ws + WS_ROUTE + RT_TILE); const int ntiles = TILE[0];
            pg8::Gemm g{512}; pg8::MoeOrder S; S.ntiles = ntiles; S.nN = 4; S.nwg = ntiles * 4; S.G = F.G; S.c = F.bid; S.tile_e = TILE + 1;
            S.A = (const char*)(F.ws + WS_H); S.W = (const char*)(F.ws + WS_W2) + (size_t)l * 32 * 1024 * 512 * 2; S.a_tile = (size_t)256 * 512 * 2; S.w_exp = (size_t)1024 * 512 * 2; S.w_tile = (size_t)256 * 512 * 2;
            pg8::EpiGate E{(bf16*)(F.ws + WS_XS), (const float*)(F.ws + WS_ROUTE + RT_SLOTW)};
            pg8::gemm_phase<pg8::EpiGate, pg8::MoeOrder, true, true>(ldsl, g, S, E, F.tid);
        }
        SEAM(pb + 8);
        if (PHE(10) && IN(pb + 9)) { PB(); combine_rows(F, l, l + 1 < DEPTH); }
        SEAM(pb + 9);
    }
#undef IN
#undef SEAM
}

extern "C" void kernel_launch(void* const* d_in, const int* in_sizes, int n_in, void* d_out, int out_size, void* d_ws, size_t ws_size, hipStream_t stream) {
    static int grid = 0;
    if (grid == 0) {
        if (n_in != 35 || out_size != NTOK * DM || ws_size < WS_END) { fprintf(stderr, "kernel_launch: unexpected shapes (n_in %d out %d ws %zu)\n", n_in, out_size, ws_size); grid = -1; return; }
        int dev = 0, cus = 0;
        if (hipGetDevice(&dev) != hipSuccess || hipDeviceGetAttribute(&cus, hipDeviceAttributeMultiprocessorCount, dev) != hipSuccess) { grid = -1; return; }
        if (hipFuncSetAttribute((const void*)mk_fwd, hipFuncAttributeMaxDynamicSharedMemorySize, LDS_BYTES) != hipSuccess) { fprintf(stderr, "kernel_launch: hipFuncSetAttribute failed\n"); grid = -1; return; }
        (void)hipGetLastError();
        grid = cus;
        if (grid != 256) { fprintf(stderr, "kernel_launch: built for 256 CUs, got %d\n", grid); grid = 256; }
    }
    if (grid < 0) return;
    (void)hipMemsetAsync((char*)d_ws + WS_CTL, 0, CTL_ZERO_BYTES, stream);
    Args a{};
    for (int i = 0; i < 35; ++i) a.in[i] = (const float*)d_in[i];
    a.out = (float*)d_out; a.ws = (unsigned char*)d_ws;
#if MK_ONE_LAUNCH
    a.ph_lo = 0; a.ph_hi = N_PHASES;
    hipLaunchKernelGGL(mk_fwd, dim3(grid), dim3(NWAVES * 64), LDS_BYTES, stream, a);
#else
    for (int p = 0; p < N_PHASES; ++p) { if (p == 1 + PH_PER_LAYER) continue; a.ph_lo = p; a.ph_hi = p + 1; hipLaunchKernelGGL(mk_fwd, dim3(grid), dim3(NWAVES * 64), LDS_BYTES, stream, a); }
#endif
}
```

```cpp
#include <hip/hip_runtime.h>
#include <cstdio>
#include <cstdint>

#ifndef MK_ONE_LAUNCH
#define MK_ONE_LAUNCH 1
#endif

namespace pg8 {
#define PG8_LAS __attribute__((address_space(3)))
typedef unsigned short bf16_t;
typedef short bf16x8 __attribute__((ext_vector_type(8)));
typedef float f32x4 __attribute__((ext_vector_type(4)));
typedef unsigned u32x4 __attribute__((ext_vector_type(4)));
typedef unsigned u32x2 __attribute__((ext_vector_type(2)));
constexpr int BM = 256, BK = 64, HALF = 128, HTB = HALF * BK * 2  , STAGE_BYTES = 8 * HTB, NXCD = 8, WGM = 8;

__host__ __device__ __forceinline__ int lds_byte(int r, int c) { const int st = (r >> 4) * 2 + (c >> 5), rr = r & 15, cc = c & 31, ob = rr * 64 + cc * 2; return st * 1024 + (ob ^ (((ob >> 9) & 1) << 5)); }
__host__ __device__ __forceinline__ void stage_rc(int b, int& R, int& C) { const int st = b / 1024, sb = b % 1024, swz = sb ^ (((sb >> 9) & 1) << 5); R = (st >> 1) * 16 + swz / 64; C = (st & 1) * 32 + (swz % 64) / 2; }
__host__ __device__ __forceinline__ int perm32(int rho) { const int n = rho >> 4, i = rho & 15; return 8 * (i >> 2) + 4 * n + (i & 3); }

struct Unit { int pm, pn; const char* a; const char* b; };
struct Gemm { int K; };

__device__ __forceinline__ int xcd_remap(int wgid, int nwg) { const int q = nwg / NXCD, r = nwg % NXCD, xcd = wgid % NXCD, off = wgid / NXCD; return (xcd < r ? xcd * (q + 1) : r * (q + 1) + (xcd - r) * q) + off; }

struct DenseOrder {
    int nM, nN, nwg, G, c; const char* A; const char* Bt; size_t tstep;
    __device__ __forceinline__ void init(const void* A_, const void* Bt_, int M, int N, int K, int G_, int c_) { A = (const char*)A_; Bt = (const char*)Bt_; nM = M / BM; nN = N / BM; nwg = nM * nN; G = G_; c = c_; tstep = (size_t)BM * K * 2; }
    __device__ __forceinline__ bool next(int i, Unit& u) const {
        const long L = (long)i * G + c; if (L >= nwg) return false;
        const int wgid = xcd_remap((int)L, nwg);
        const int nig = WGM * nN, gid = wgid / nig, fm = gid * WGM, gsz = (nM - fm) < WGM ? (nM - fm) : WGM;
        u.pm = fm + ((wgid % nig) % gsz); u.pn = (wgid % nig) / gsz; u.a = A + (size_t)u.pm * tstep; u.b = Bt + (size_t)u.pn * tstep; return true;
    }
    __device__ __forceinline__ void a_ready(const Unit&) const {}
    __device__ __forceinline__ void done(const Unit&) const {}
};
struct MoeOrder {
    int ntiles, nN, nwg, G, c; const int* tile_e; const char* A; const char* W; size_t a_tile, w_exp, w_tile;
    __device__ __forceinline__ bool next(int i, Unit& u) const {
        const long L = (long)i * G + c; if (L >= nwg) return false;
        const int wgid = xcd_remap((int)L, nwg);
        const int ti = wgid / nN, pn = wgid % nN; const int e = tile_e[ti];
        u.pm = ti; u.pn = pn; u.a = A + (size_t)ti * a_tile; u.b = W + (size_t)e * w_exp + (size_t)pn * w_tile; return true;
    }
    __device__ __forceinline__ void a_ready(const Unit&) const {}
    __device__ __forceinline__ void done(const Unit&) const {}
};

__device__ __forceinline__ unsigned cvt_pk_bf16(float lo, float hi) { unsigned r; asm volatile("v_cvt_pk_bf16_f32 %0, %1, %2" : "=v"(r) : "v"(lo), "v"(hi)); return r; }

struct EpiBf16 {
    static constexpr bool PERM = true, AFTER_DRAIN = false;
    bf16_t* O; int ldc;
    __device__ __forceinline__ void operator()(const f32x4 (&acc)[2][2][4][2], const Unit& u, int wr, int wc, int fr, int fq) const {
        const int row0 = u.pm * BM + wr * 64 + fr; const int col0 = u.pn * BM + wc * 32 + 8 * fq;
#pragma unroll
        for (int ai = 0; ai < 2; ++ai)
#pragma unroll
            for (int m = 0; m < 4; ++m) { bf16_t* rowp = O + (size_t)(row0 + ai * HALF + m * 16) * ldc + col0;
#pragma unroll
                for (int bj = 0; bj < 2; ++bj) { const f32x4 v0 = acc[ai][bj][m][0], v1 = acc[ai][bj][m][1];
                    u32x4 w; w.x = cvt_pk_bf16(v0[0], v0[1]); w.y = cvt_pk_bf16(v0[2], v0[3]); w.z = cvt_pk_bf16(v1[0], v1[1]); w.w = cvt_pk_bf16(v1[2], v1[3]);
                    *(u32x4*)(rowp + bj * HALF) = w; } }
    }
};
struct EpiRes {
    static constexpr bool PERM = false, AFTER_DRAIN = false;
    const float* xres; float* out; const float* gt;
    __device__ __forceinline__ void operator()(const f32x4 (&acc)[2][2][4][2], const Unit& u, int wr, int wc, int fr, int fq) const {
        const int row0 = u.pm * BM + wr * 64 + fr; const int col0 = u.pn * BM + wc * 32 + 4 * fq; const float* g = gt + (size_t)(u.pm >> 3) * 6144 + col0;
        f32x4 gv[2][2];
#pragma unroll
        for (int bj = 0; bj < 2; ++bj)
#pragma unroll
            for (int n = 0; n < 2; ++n) gv[bj][n] = *(const f32x4*)(g + bj * HALF + n * 16);
#pragma unroll
        for (int ai = 0; ai < 2; ++ai)
#pragma unroll
            for (int m = 0; m < 4; ++m) { const size_t off = (size_t)(row0 + ai * HALF + m * 16) * 1024 + col0;
#pragma unroll
                for (int bj = 0; bj < 2; ++bj)
#pragma unroll
                    for (int n = 0; n < 2; ++n) { const f32x4 xv = *(const f32x4*)(xres + off + bj * HALF + n * 16); *(f32x4*)(out + off + bj * HALF + n * 16) = xv + gv[bj][n] * acc[ai][bj][m][n]; } }
    }
};
struct EpiSwiGLU {
    static constexpr bool PERM = true, AFTER_DRAIN = false;
    bf16_t* H;
    __device__ __forceinline__ void operator()(const f32x4 (&acc)[2][2][4][2], const Unit& u, int wr, int wc, int fr, int fq) const {
        const int row0 = u.pm * BM + wr * 64 + fr; const int hcol0 = u.pn * 128 + wc * 16 + 4 * fq;
#pragma unroll
        for (int ai = 0; ai < 2; ++ai)
#pragma unroll
            for (int m = 0; m < 4; ++m) { bf16_t* rowp = H + (size_t)(row0 + ai * HALF + m * 16) * 512 + hcol0;
#pragma unroll
                for (int bj = 0; bj < 2; ++bj) { const f32x4 a = acc[ai][bj][m][0], b = acc[ai][bj][m][1]; f32x4 o;
#pragma unroll
                    for (int i = 0; i < 4; ++i) o[i] = a[i] * __builtin_amdgcn_rcpf(1.0f + __expf(-a[i])) * b[i];
                    u32x2 w; w.x = cvt_pk_bf16(o[0], o[1]); w.y = cvt_pk_bf16(o[2], o[3]);
                    *(u32x2*)(rowp + bj * 64) = w; } }
    }
};
struct EpiGate {
    static constexpr bool PERM = true, AFTER_DRAIN = false;
    bf16_t* O; const float* rs;
    __device__ __forceinline__ void operator()(const f32x4 (&acc)[2][2][4][2], const Unit& u, int wr, int wc, int fr, int fq) const {
        const int row0 = u.pm * BM + wr * 64 + fr; const int col0 = u.pn * BM + wc * 32 + 8 * fq;
#pragma unroll
        for (int ai = 0; ai < 2; ++ai)
#pragma unroll
            for (int m = 0; m < 4; ++m) { const int row = row0 + ai * HALF + m * 16; const float s = rs[row]; bf16_t* rowp = O + (size_t)row * 1024 + col0;
#pragma unroll
                for (int bj = 0; bj < 2; ++bj) { const f32x4 v0 = acc[ai][bj][m][0] * s, v1 = acc[ai][bj][m][1] * s;
                    u32x4 w; w.x = cvt_pk_bf16(v0[0], v0[1]); w.y = cvt_pk_bf16(v0[2], v0[3]); w.z = cvt_pk_bf16(v1[0], v1[1]); w.w = cvt_pk_bf16(v1[2], v1[3]);
                    *(u32x4*)(rowp + bj * HALF) = w; } }
    }
};
template <class Epi, class Sched, bool ALIGN_EPI = false, bool SP2 = false>
__device__ __forceinline__ void gemm_phase(PG8_LAS unsigned char* lds, const Gemm g, const Sched& S, const Epi& E, const int tid) {
    const int wid = __builtin_amdgcn_readfirstlane(tid >> 6), lane = tid & 63, wr = wid >> 2, wc = wid & 3, fr = lane & 15, fq = lane >> 4;
    const int K = g.K, nt = K / BK;
    unsigned voffA[2], voffB[2];
#pragma unroll
    for (int i = 0; i < 2; ++i) { int R, C; stage_rc(tid * 16 + i * 8192, R, C); const int Rb = Epi::PERM ? ((R & ~31) + perm32(R & 31)) : R;
        voffA[i] = (unsigned)(R * K + C) * 2u; voffB[i] = (unsigned)(Rb * K + C) * 2u; }
    const size_t kstep = (size_t)(BK * 2);
    const size_t hstep = (size_t)HALF * K * 2;
    const size_t tstep = 2 * hstep;
    const unsigned ldsw = (unsigned)wid * 1024u;
    const int aoff = lds_byte(wr * 64 + fr, fq * 8), boff = lds_byte(wc * 32 + fr, fq * 8);
#define PG8_SA(b, h) (((b) * 2 + (h)) * HTB)
#define PG8_SB(b, h) ((4 + (b) * 2 + (h)) * HTB)
#define PG8_STAGE(bufoff, gbase, voff) do { _Pragma("unroll") for (int _i = 0; _i < 2; ++_i) \
        __builtin_amdgcn_global_load_lds((const unsigned*)((const char*)(gbase) + (voff)[_i]), (PG8_LAS unsigned*)(lds + (bufoff) + ldsw + _i * 8192), 16, 0, 0); } while (0)
#define PG8_LDA(dst, b, h) do { _Pragma("unroll") for (int m = 0; m < 4; ++m) _Pragma("unroll") for (int k = 0; k < 2; ++k) dst[m][k] = *(const PG8_LAS bf16x8*)(lds + PG8_SA(b, h) + aoff + m * 2048 + k * 1024); } while (0)
#define PG8_LDB(dst, b, h) do { _Pragma("unroll") for (int n = 0; n < 2; ++n) _Pragma("unroll") for (int k = 0; k < 2; ++k) dst[n][k] = *(const PG8_LAS bf16x8*)(lds + PG8_SB(b, h) + boff + n * 2048 + k * 1024); } while (0)
#define PG8_MMA(ai, bj, At, Bt) do { __builtin_amdgcn_s_setprio(1); _Pragma("unroll") for (int m = 0; m < 4; ++m) _Pragma("unroll") for (int n = 0; n < 2; ++n) _Pragma("unroll") for (int k = 0; k < 2; ++k) \
        acc[ai][bj][m][n] = __builtin_amdgcn_mfma_f32_16x16x32_bf16(Bt[n][k], At[m][k], acc[ai][bj][m][n], 0, 0, 0); __builtin_amdgcn_s_setprio(0); } while (0)
#define PG8_WAIT_V(n) asm volatile("s_waitcnt vmcnt(" #n ")" ::: "memory")
#define PG8_WAIT_L(n) asm volatile("s_waitcnt lgkmcnt(" #n ")" ::: "memory")
#define PG8_BAR __builtin_amdgcn_s_barrier()
#define PG8_SCHED __builtin_amdgcn_sched_barrier(0)
    Unit cur, nxt; int ui = 0;
    if (!S.next(0, cur)) return;
    f32x4 acc[2][2][4][2];
#pragma unroll
    for (int a = 0; a < 2; ++a)
#pragma unroll
        for (int b = 0; b < 2; ++b)
#pragma unroll
            for (int m = 0; m < 4; ++m)
#pragma unroll
                for (int n = 0; n < 2; ++n) acc[a][b][m][n] = (f32x4){0.f, 0.f, 0.f, 0.f};
    bf16x8 At[4][2], B0[2][2], B1[2][2];
    const char* cA = cur.a; const char* cB = cur.b;
    S.a_ready(cur);
    if constexpr (SP2) {
        PG8_STAGE(PG8_SB(0, 0), cB, voffB); PG8_STAGE(PG8_SB(0, 1), cB + hstep, voffB); PG8_STAGE(PG8_SA(0, 0), cA, voffA); PG8_STAGE(PG8_SA(0, 1), cA + hstep, voffA);
        if (wr == 1) PG8_BAR;
        PG8_WAIT_V(2); PG8_BAR;
        PG8_STAGE(PG8_SB(1, 0), cB + kstep, voffB); PG8_STAGE(PG8_SA(1, 0), cA + kstep, voffA); PG8_STAGE(PG8_SB(1, 1), cB + hstep + kstep, voffB);
        PG8_WAIT_V(6); PG8_BAR;
    } else {
        PG8_STAGE(PG8_SB(0, 0), cB, voffB); PG8_STAGE(PG8_SA(0, 0), cA, voffA); PG8_STAGE(PG8_SB(0, 1), cB + hstep, voffB); PG8_STAGE(PG8_SA(0, 1), cA + hstep, voffA);
        if (wr == 1) PG8_BAR;
        PG8_WAIT_V(4); PG8_BAR;
        PG8_STAGE(PG8_SB(1, 0), cB + kstep, voffB); PG8_STAGE(PG8_SA(1, 0), cA + kstep, voffA); PG8_STAGE(PG8_SB(1, 1), cB + hstep + kstep, voffB);
        PG8_WAIT_V(6); PG8_BAR;
    }
    for (;;) {
        const bool has_next = S.next(ui + 1, nxt);
        const char* nA = has_next ? nxt.a : cA; const char* nB = has_next ? nxt.b : cB;
        for (int t = 0; t < nt; t += 2) {
            const bool last = (t == nt - 2);
            const char* a1 = cA + (size_t)(t + 1) * kstep;
            const char* a2 = last ? nA : cA + (size_t)(t + 2) * kstep; const char* b2 = last ? nB : cB + (size_t)(t + 2) * kstep;
            const char* a3 = a2 + kstep; const char* b3 = b2 + kstep;
            if (last && has_next) S.a_ready(nxt);
            if constexpr (SP2) {
            PG8_LDB(B0, 0, 0); PG8_LDB(B1, 0, 1); PG8_SCHED; PG8_LDA(At, 0, 0); PG8_STAGE(PG8_SA(1, 1), a1 + hstep, voffA);
            PG8_WAIT_V(8); PG8_WAIT_L(0); PG8_BAR; PG8_MMA(0, 0, At, B0); PG8_MMA(0, 1, At, B1); PG8_BAR; PG8_SCHED;
            PG8_LDA(At, 0, 1); PG8_STAGE(PG8_SB(0, 0), b2, voffB); PG8_STAGE(PG8_SB(0, 1), b2 + hstep, voffB); PG8_STAGE(PG8_SA(0, 0), a2, voffA);
            PG8_WAIT_V(8); PG8_WAIT_L(0); PG8_BAR; PG8_MMA(1, 0, At, B0); PG8_MMA(1, 1, At, B1); PG8_BAR; PG8_SCHED;
            PG8_LDB(B0, 1, 0); PG8_LDB(B1, 1, 1); PG8_SCHED; PG8_LDA(At, 1, 0); PG8_STAGE(PG8_SA(0, 1), a2 + hstep, voffA);
            PG8_WAIT_V(8); PG8_WAIT_L(0); PG8_BAR; PG8_MMA(0, 0, At, B0); PG8_MMA(0, 1, At, B1); PG8_BAR; PG8_SCHED;
            PG8_LDA(At, 1, 1); PG8_STAGE(PG8_SB(1, 0), b3, voffB); PG8_STAGE(PG8_SB(1, 1), b3 + hstep, voffB); PG8_STAGE(PG8_SA(1, 0), a3, voffA);
            PG8_WAIT_V(8); PG8_WAIT_L(0); PG8_BAR; PG8_MMA(1, 0, At, B0); PG8_MMA(1, 1, At, B1); PG8_BAR; PG8_SCHED;
            } else {
            PG8_LDB(B0, 0, 0); PG8_SCHED; PG8_LDA(At, 0, 0); PG8_STAGE(PG8_SA(1, 1), a1 + hstep, voffA);
            PG8_WAIT_L(8); PG8_BAR; PG8_WAIT_L(0); PG8_MMA(0, 0, At, B0); PG8_BAR; PG8_SCHED;
            PG8_LDB(B1, 0, 1); PG8_STAGE(PG8_SB(0, 0), b2, voffB);
            PG8_BAR; PG8_WAIT_L(0); PG8_MMA(0, 1, At, B1); PG8_BAR;
            PG8_LDA(At, 0, 1); PG8_STAGE(PG8_SA(0, 0), a2, voffA);
            PG8_BAR; PG8_WAIT_L(0); PG8_MMA(1, 0, At, B0); PG8_BAR; PG8_SCHED;
            PG8_STAGE(PG8_SB(0, 1), b2 + hstep, voffB);
            PG8_WAIT_V(6); PG8_BAR; PG8_MMA(1, 1, At, B1); PG8_BAR;
            PG8_LDB(B0, 1, 0); PG8_SCHED; PG8_LDA(At, 1, 0); PG8_STAGE(PG8_SA(0, 1), a2 + hstep, voffA);
            PG8_WAIT_L(8); PG8_BAR; PG8_WAIT_L(0); PG8_MMA(0, 0, At, B0); PG8_BAR; PG8_SCHED;
            PG8_LDB(B1, 1, 1); PG8_STAGE(PG8_SB(1, 0), b3, voffB);
            PG8_BAR; PG8_WAIT_L(0); PG8_MMA(0, 1, At, B1); PG8_BAR;
            PG8_LDA(At, 1, 1); PG8_STAGE(PG8_SA(1, 0), a3, voffA);
            PG8_BAR; PG8_WAIT_L(0); PG8_MMA(1, 0, At, B0); PG8_BAR; PG8_SCHED;
            PG8_STAGE(PG8_SB(1, 1), b3 + hstep, voffB);
            PG8_WAIT_V(6); PG8_BAR; PG8_MMA(1, 1, At, B1); PG8_BAR;
            }
        }
        if constexpr (ALIGN_EPI) { if (wr == 0) PG8_BAR; }
        if constexpr (!Epi::AFTER_DRAIN) { E(acc, cur, wr, wc, fr, fq); S.done(cur); }
        if (!has_next) break;
#pragma unroll
        for (int a = 0; a < 2; ++a)
#pragma unroll
            for (int b = 0; b < 2; ++b)
#pragma unroll
                for (int m = 0; m < 4; ++m)
#pragma unroll
                    for (int n = 0; n < 2; ++n) acc[a][b][m][n] = (f32x4){0.f, 0.f, 0.f, 0.f};
        cur = nxt; cA = nA; cB = nB; ++ui;
        if constexpr (ALIGN_EPI) { if (wr == 1) PG8_BAR; }
    }
    PG8_WAIT_V(0);
    if constexpr (!ALIGN_EPI) { if (wr == 0) PG8_BAR; }
    PG8_BAR;
    if constexpr (Epi::AFTER_DRAIN) { E.fused(acc, cur, wr, wc, fr, fq, lds, wid, lane); S.done(cur); }
#undef PG8_SA
#undef PG8_SB
#undef PG8_STAGE
#undef PG8_LDA
#undef PG8_LDB
#undef PG8_MMA
#undef PG8_WAIT_V
#undef PG8_WAIT_L
#undef PG8_BAR
#undef PG8_SCHED
}
}

#ifndef PH_MASK
#define PH_MASK 0x7fff
#endif
#define PHE(b) ((PH_MASK >> (b)) & 1)
#ifndef REP_MASK
#define REP_MASK 0
#endif
#define REPN(b) (1 + ((REP_MASK >> (b)) & 1))
constexpr int DM = 1024, NB = 32, SEQ = 2048, NTOK = NB * SEQ, DEPTH = 2, NWAVES = 8;
constexpr int PW = 3328;
constexpr int PREF = 3244;
constexpr int A_R = 0, A_K = 256, A_V = 512, A_WD = 768, A_AD = 800, A_GD = 832;
constexpr int B_Q = 896, B_K = 1152, B_V = 1408;
constexpr int C_Q = 1664, C_K = 1920, C_V = 2176, C_O = 2432, C_I = 2688, C_F = 2692;
constexpr int D_Q = 2752, D_K = 3008, D_V = 3072, D_QI = 3136, D_KI = 3264, D_WI = 3296;
constexpr int DREF0 = 2696;
constexpr int NEXP = 32, FF = 512;
constexpr int MAXSLOT = NTOK * 2 + NEXP * 256;
constexpr int MAXTILES = MAXSLOT / 256;

constexpr size_t MiB = 1u << 20;
constexpr size_t WS_CTL = 0, CTL_ZERO_BYTES = 1 * MiB;
constexpr size_t WS_MOD = 1 * MiB;
constexpr size_t WS_ROPE = 3 * MiB;
constexpr size_t WS_WIN = 4 * MiB;
constexpr size_t WS_WOUT = 17 * MiB;
constexpr size_t WS_WR = 21 * MiB;
constexpr size_t WS_W13 = 22 * MiB;
constexpr size_t WS_W2 = 150 * MiB;
constexpr size_t WS_ROUTE = 214 * MiB;
constexpr size_t RT_EXPERT = 0, RT_GATE = 512 * 1024, RT_TOKSLOT = 1024 * 1024, RT_SLOTW = 1536 * 1024, RT_CNT = 2304 * 1024, RT_TILE = 2368 * 1024;
constexpr size_t WS_MASK = 218 * MiB;
constexpr size_t WS_XN = 234 * MiB;
constexpr size_t WS_YCAT = 362 * MiB;
constexpr size_t WS_P = 490 * MiB;
constexpr size_t WS_XS = WS_P;
constexpr size_t WS_H = WS_P + 272 * MiB;
constexpr size_t WS_END = 906 * MiB;
static_assert(WS_H + (size_t)MAXSLOT * 512 * 2 <= WS_END && WS_P + (size_t)NTOK * PW * 2 <= WS_END, "ws map");
constexpr int CW_Q = 64;
constexpr int CW_BAR = 4096;

constexpr int LDS_BYTES = 155648;
constexpr int MISC_OFF = 153600;

#define GAS __attribute__((address_space(1)))
#define LAS __attribute__((address_space(3)))
typedef unsigned short bf16;
typedef unsigned v4u __attribute__((ext_vector_type(4)));
typedef float f32x4 __attribute__((ext_vector_type(4)));
typedef short bf16x8 __attribute__((ext_vector_type(8)));
typedef GAS unsigned gu32;
typedef GAS unsigned long long gu64;
#define RLX_AGENT __ATOMIC_RELAXED, __HIP_MEMORY_SCOPE_AGENT
#define LDS_WAIT() asm volatile("s_waitcnt lgkmcnt(0)" ::: "memory")
#define VM_WAIT() asm volatile("s_waitcnt vmcnt(0)" ::: "memory")
__device__ __forceinline__ unsigned long long rt() { return __builtin_amdgcn_s_memrealtime(); }
__device__ __forceinline__ unsigned f2bf(float f) { unsigned u = __builtin_bit_cast(unsigned, f); return (u + 0x7fffu + ((u >> 16) & 1u)) >> 16; }
__device__ __forceinline__ unsigned pk2(float lo, float hi) { return f2bf(lo) | (f2bf(hi) << 16); }

#define XB_TMO      128
#define XB_XCNT(j)  (256  + 64 * (j))
#define XB_XSUB(j)  (1280 + 64 * (j))
#define XB_XGEN(j)  (2304 + 64 * (j))
#define XB_TOP      3328
#define XB_TOPGEN   3392
#define XCD_BAR_WORDS 3456
#define XB_SPIN_CAP (1u << 18)

__device__ __forceinline__ unsigned xb_ld(unsigned* p)              { return __hip_atomic_load(p, __ATOMIC_RELAXED, __HIP_MEMORY_SCOPE_AGENT); }
__device__ __forceinline__ unsigned xb_add(unsigned* p, unsigned v) { return __hip_atomic_fetch_add(p, v, __ATOMIC_RELAXED, __HIP_MEMORY_SCOPE_AGENT); }
__device__ __forceinline__ unsigned xb_xcc_id() { return (unsigned)__builtin_amdgcn_s_getreg((3 << 11) | 20) & 0xFu; }
#define XB_SPIN(cond, bar) do { unsigned _sp = 0; while (cond) { __builtin_amdgcn_s_sleep(1); \
    if ((++_sp & 255u) == 0u) { if (xb_ld(&(bar)[XB_TMO])) break; if (_sp > XB_SPIN_CAP) { atomicAdd(&(bar)[XB_TMO], 1u); break; } } } } while (0)

struct XcdBarrier {
    unsigned* bar; unsigned x;
    volatile LAS unsigned* st;
};

__device__ __forceinline__ XcdBarrier xcd_barrier_post(unsigned* bar, volatile LAS unsigned* st) {
    XcdBarrier b; b.bar = bar; b.x = xb_xcc_id(); b.st = st;
    if (threadIdx.x == 0) (void)xb_add(&bar[XB_XCNT(b.x)], 1u);
    return b;
}
__device__ __forceinline__ void xcd_barrier_complete(unsigned* bar, unsigned x, unsigned& nloc, unsigned& nx) {
    const unsigned G = gridDim.x * gridDim.y * gridDim.z;
    unsigned sum, cnt, mine, sp = 0u;
    for (;;) {
        sum = 0u; cnt = 0u; mine = 0u;
#pragma unroll
        for (unsigned j = 0; j < 16; ++j) { const unsigned c = xb_ld(&bar[XB_XCNT(j)]); sum += c; cnt += (c > 0u) ? 1u : 0u; mine = (j == x) ? c : mine; }
        if (sum == G) break;
        __builtin_amdgcn_s_sleep(1);
        if ((++sp & 255u) == 0u) { if (xb_ld(&bar[XB_TMO])) break; if (sp > XB_SPIN_CAP) { atomicAdd(&bar[XB_TMO], 1u); break; } }
    }
    nloc = mine > 0u ? mine : 1u; nx = cnt > 0u ? cnt : 1u;
}

__device__ __forceinline__ void xcd_barrier(const XcdBarrier& b) {
    asm volatile("s_waitcnt vmcnt(0)" ::: "memory");
    __syncthreads();
    if (threadIdx.x == 0) {
        unsigned* bar = b.bar;
        __builtin_amdgcn_s_waitcnt(0);
        unsigned nloc = b.st[0], nx = b.st[1];
        if (nloc == 0u) { xcd_barrier_complete(bar, b.x, nloc, nx); b.st[0] = nloc; b.st[1] = nx; }
        const unsigned old = xb_add(&bar[XB_XSUB(b.x)], 1u);
        const unsigned gen = old / nloc;
        if (old + 1u == (gen + 1u) * nloc) {
            __builtin_amdgcn_fence(__ATOMIC_RELEASE, "agent");
            asm volatile("s_waitcnt vmcnt(0)" ::: "memory");
            const unsigned og = xb_add(&bar[XB_TOP], 1u);
            const unsigned tg = og / nx;
            if (og + 1u == (tg + 1u) * nx) xb_add(&bar[XB_TOPGEN], 1u);
            else XB_SPIN(xb_ld(&bar[XB_TOPGEN]) == tg, bar);
            __builtin_amdgcn_fence(__ATOMIC_ACQUIRE, "agent");
            xb_add(&bar[XB_XGEN(b.x)], 1u);
            asm volatile("s_waitcnt vmcnt(0)" ::: "memory");
        } else {
            XB_SPIN(xb_ld(&bar[XB_XGEN(b.x)]) == gen, bar);
            __builtin_amdgcn_fence(__ATOMIC_ACQUIRE, "agent");
            asm volatile("s_waitcnt vmcnt(0)" ::: "memory");
        }
    }
    __syncthreads();
}

struct Args { const float* in[35]; float* out; unsigned char* ws; int ph_lo, ph_hi; };
typedef float f32x16 __attribute__((ext_vector_type(16)));
typedef unsigned u32x2v __attribute__((ext_vector_type(2)));
struct Frame {
    unsigned char* lds;
    gu32* ctl;
    int tid, lane, wave, vcu, G, bid;
    const Args* A;
    float* out; unsigned char* ws;
};
enum { I_X = 0, I_C, I_ADAW, I_ADAB, I_N1G, I_N2G, I_WIN, I_MU, I_W0, I_W2, I_A0, I_A2, I_G2, I_KK, I_KA, I_RK, I_LNG, I_LNB, I_SBG, I_CONVW, I_CONVB, I_IGB, I_FGB, I_MLG,
       I_QNG, I_KNG, I_DOG, I_WOUT, I_WG, I_BG, I_WE, I_BE, I_MW1, I_MW3, I_MW2 };

__device__ __forceinline__ float bf2f(unsigned short u) { return __uint_as_float(((unsigned)u) << 16); }
__device__ __forceinline__ float bflo(unsigned u) { return __uint_as_float(u << 16); }
__device__ __forceinline__ float bfhi(unsigned u) { return __uint_as_float(u & 0xffff0000u); }
__device__ __forceinline__ float sigmoidf_(float x) { return __builtin_amdgcn_rcpf(1.0f + __expf(-x)); }
__device__ __forceinline__ float softplusf_(float x) { return fmaxf(x, 0.f) + __logf(1.0f + __expf(-fabsf(x))); }
__device__ __forceinline__ float wave_sum(float v) {
#pragma unroll
    for (int o = 1; o < 64; o <<= 1) v += __shfl_xor(v, o);
    return v;
}
__device__ __forceinline__ float sum16(float v) { v += __shfl_xor(v, 1); v += __shfl_xor(v, 2); v += __shfl_xor(v, 4); v += __shfl_xor(v, 8); return v; }
__device__ __forceinline__ float sum8(float v) { v += __shfl_xor(v, 1); v += __shfl_xor(v, 2); v += __shfl_xor(v, 4); return v; }

__device__ __forceinline__ int rowmap(int mode, int n) {
    if (mode == 1) return n < DREF0 ? n : n + (D_Q - DREF0);
    if (mode == 2) return 8 * (n >> 2) + (n & 3);
    if (mode == 3) return 8 * (n >> 2) + 4 + (n & 3);
    return n;
}
__device__ __forceinline__ void tr_item(const float* W, int K, int N, bf16* WT, int mode, float* scr, int kb, int nb, int lane) {
    const int k0 = 64 * kb, n0 = 32 * nb;
    const int nn = n0 + (lane & 31);
#pragma unroll 8
    for (int i = 0; i < 32; ++i) { const int kk = 2 * i + (lane >> 5); scr[kk * 33 + (lane & 31)] = (nn < N) ? W[(size_t)(k0 + kk) * N + nn] : 0.f; }
    LDS_WAIT(); asm volatile("" ::: "memory");
    const int c = lane & 7;
#pragma unroll
    for (int j = 0; j < 4; ++j) { const int nl = (lane >> 3) + 8 * j; const int n = n0 + nl; const float* s = scr + (8 * c) * 33 + nl;
        v4u o; o.x = pk2(s[0 * 33], s[1 * 33]); o.y = pk2(s[2 * 33], s[3 * 33]); o.z = pk2(s[4 * 33], s[5 * 33]); o.w = pk2(s[6 * 33], s[7 * 33]);
        if (n < N) *(v4u*)(WT + (size_t)rowmap(mode, n) * K + k0 + 8 * c) = o; }
    LDS_WAIT(); asm volatile("" ::: "memory");
}
__device__ __forceinline__ void p0_prologue(Frame& F) {
    unsigned char* ws = F.ws;
    __syncthreads();
    if (F.bid < 192) {
        float* ca = (float*)F.lds;
        const float* c = F.A->in[I_C];
        for (int idx = F.tid; idx < 32768; idx += 512) { const int b = idx & 31, k = idx >> 5; const float cv = c[b * 1024 + k]; ca[idx] = cv * sigmoidf_(cv); }
        __syncthreads();
        const int l = F.bid / 96, cb = F.bid % 96; const int col = cb * 64 + (F.tid & 63), bg = F.tid >> 6;
        const float* W = F.A->in[I_ADAW] + (size_t)l * 1024 * 6144 + col;
        f32x4 acc = {0.f, 0.f, 0.f, 0.f};
#pragma unroll 8
        for (int k = 0; k < 1024; ++k) { const float w = W[(size_t)k * 6144]; const f32x4 cv = *(const f32x4*)(ca + k * 32 + 4 * bg); acc += w * cv; }
        const float bb = F.A->in[I_ADAB][l * 6144 + col];
        float* MOD = (float*)(ws + WS_MOD) + (size_t)l * 32 * 6144;
#pragma unroll
        for (int i = 0; i < 4; ++i) MOD[(size_t)(4 * bg + i) * 6144 + col] = acc[i] + bb;
        __syncthreads();
    }
    const int gt = F.bid * 512 + F.tid, NGT = F.G * 512;
    { float* rope = (float*)(ws + WS_ROPE);
      for (int idx = gt; idx < 2048 * 32; idx += NGT) { const int pos = idx >> 5, i = idx & 31; const float inv = powf(10000.0f, -(float)i / 32.0f); const float ang = (float)pos * inv; float s, c; sincosf(ang, &s, &c); rope[2 * idx] = c; rope[2 * idx + 1] = s; } }
    { bf16* wr = (bf16*)(ws + WS_WR);
      for (int idx = gt; idx < 2 * 36 * 1024; idx += NGT) { const int l = idx / (36 * 1024), r = idx % (36 * 1024), o = r >> 10, k = r & 1023;
          const float v = (o < 4) ? F.A->in[I_WG][((size_t)l * 1024 + k) * 4 + o] : F.A->in[I_WE][((size_t)l * 1024 + k) * 32 + (o - 4)]; wr[idx] = (bf16)f2bf(v); } }
    { bf16* win = (bf16*)(ws + WS_WIN);
      for (int idx = gt; idx < 2 * 84 * 128; idx += NGT) { const int l = idx / (84 * 128), r = idx % (84 * 128), rr = r >> 7, ch = r & 127; const int row = rr < 56 ? DREF0 + rr : 3300 + (rr - 56);
          *(v4u*)(win + ((size_t)l * PW + row) * 1024 + ch * 8) = (v4u){0u, 0u, 0u, 0u}; } }
    float* scr = (float*)(F.lds + F.wave * 16384);
    const int gw = F.vcu * NWAVES + F.wave, NGW = F.G * NWAVES;
    constexpr int I_IN = 16 * 102, I_OUT = 16 * 32, I_E = 256;
    constexpr int N_IN = 2 * I_IN, N_OUT = 2 * I_OUT, N_E = 64 * I_E;
    constexpr int NITEMS = N_IN + N_OUT + 3 * N_E;
    for (int it = gw; it < NITEMS; it += NGW) {
        int r = it;
        if (r < N_IN) { const int l = r / I_IN, q = r % I_IN; tr_item(F.A->in[I_WIN] + (size_t)l * 1024 * PREF, 1024, PREF, (bf16*)(ws + WS_WIN) + (size_t)l * PW * 1024, 1, scr, q / 102, q % 102, F.lane); continue; } r -= N_IN;
        if (r < N_OUT) { const int l = r / I_OUT, q = r % I_OUT; tr_item(F.A->in[I_WOUT] + (size_t)l * 1024 * 1024, 1024, 1024, (bf16*)(ws + WS_WOUT) + (size_t)l * 1024 * 1024, 0, scr, q / 32, q % 32, F.lane); continue; } r -= N_OUT;
        if (r < N_E) { const int le = r / I_E, q = r % I_E; tr_item(F.A->in[I_MW1] + (size_t)le * 1024 * 512, 1024, 512, (bf16*)(ws + WS_W13) + (size_t)le * 1024 * 1024, 2, scr, q / 16, q % 16, F.lane); continue; } r -= N_E;
        if (r < N_E) { const int le = r / I_E, q = r % I_E; tr_item(F.A->in[I_MW3] + (size_t)le * 1024 * 512, 1024, 512, (bf16*)(ws + WS_W13) + (size_t)le * 1024 * 1024, 3, scr, q / 16, q % 16, F.lane); continue; } r -= N_E;
        { const int le = r / I_E, q = r % I_E; tr_item(F.A->in[I_MW2] + (size_t)le * 512 * 1024, 512, 1024, (bf16*)(ws + WS_W2) + (size_t)le * 1024 * 512, 0, scr, q / 32, q % 32, F.lane); }
    }
}

__device__ __forceinline__ void norm_rows(Frame& F, const float* xsrc, int l, int which  ) {
    const int gw = F.bid * NWAVES + F.wave; const int m0 = gw * 32, b = m0 >> 11;
    const float* g = (which ? F.A->in[I_N2G] : F.A->in[I_N1G]) + l * 1024;
    const float* MOD = (const float*)(F.ws + WS_MOD) + ((size_t)l * 32 + b) * 6144 + which * 3072;
    f32x4 mul[4], add[4];
#pragma unroll
    for (int j = 0; j < 4; ++j) { const int e = 4 * (F.lane + 64 * j); const f32x4 gv = *(const f32x4*)(g + e), sc = *(const f32x4*)(MOD + 1024 + e); mul[j] = gv * (1.0f + sc); add[j] = *(const f32x4*)(MOD + e); }
    bf16* XN = (bf16*)(F.ws + WS_XN);
    for (int r = 0; r < 32; ++r) {
        const size_t m = (size_t)(m0 + r);
        const f32x4* xr = (const f32x4*)(xsrc + m * 1024) + F.lane;
        f32x4 v[4]; float s = 0.f;
#pragma unroll
        for (int j = 0; j < 4; ++j) { v[j] = xr[64 * j]; s += (v[j].x * v[j].x + v[j].y * v[j].y) + (v[j].z * v[j].z + v[j].w * v[j].w); }
        const float rs = rsqrtf(wave_sum(s) * (1.0f / 1024.0f) + 1e-6f);
        unsigned long long* o8 = (unsigned long long*)(XN + m * 1024) + F.lane;
#pragma unroll
        for (int j = 0; j < 4; ++j) { const f32x4 h = v[j] * rs * mul[j] + add[j]; o8[64 * j] = (unsigned long long)pk2(h.x, h.y) | ((unsigned long long)pk2(h.z, h.w) << 32); }
    }
}

__device__ __forceinline__ void norm2_route(Frame& F, int l) {
    unsigned char* ws = F.ws;
    unsigned* wrl = (unsigned*)F.lds;
    int* hist = (int*)(F.lds + 73728);
    { const v4u* src = (const v4u*)((const bf16*)(ws + WS_WR) + (size_t)l * 36 * 1024); v4u* dst = (v4u*)F.lds;
      for (int i = F.tid; i < 36 * 1024 * 2 / 16; i += 512) dst[i] = src[i];
      if (F.tid < 32) hist[F.tid] = 0; }
    __syncthreads();
    const int gw = F.bid * NWAVES + F.wave; const int m0 = gw * 32, b = m0 >> 11;
    const float* g = F.A->in[I_N2G] + l * 1024;
    const float* MOD = (const float*)(ws + WS_MOD) + ((size_t)l * 32 + b) * 6144 + 3072;
    f32x4 mul[4], add[4];
#pragma unroll
    for (int j = 0; j < 4; ++j) { const int e = 4 * (F.lane + 64 * j); const f32x4 gv = *(const f32x4*)(g + e), sc = *(const f32x4*)(MOD + 1024 + e); mul[j] = gv * (1.0f + sc); add[j] = *(const f32x4*)(MOD + e); }
    bf16* XN = (bf16*)(ws + WS_XN);
    int* EXPERT = (int*)(ws + WS_ROUTE + RT_EXPERT); float* GATE = (float*)(ws + WS_ROUTE + RT_GATE);
    const float* bgp = F.A->in[I_BG] + l * 4; const float* bep = F.A->in[I_BE] + l * 32;
    const float* xsrc = F.out;
    for (int r = 0; r < 32; ++r) {
        const size_t m = (size_t)(m0 + r);
        const f32x4* xr = (const f32x4*)(xsrc + m * 1024) + F.lane;
        f32x4 v[4]; float s = 0.f;
#pragma unroll
        for (int j = 0; j < 4; ++j) { v[j] = xr[64 * j]; s += (v[j].x * v[j].x + v[j].y * v[j].y) + (v[j].z * v[j].z + v[j].w * v[j].w); }
        const float rs = rsqrtf(wave_sum(s) * (1.0f / 1024.0f) + 1e-6f);
        unsigned long long* o8 = (unsigned long long*)(XN + m * 1024) + F.lane;
#pragma unroll
        for (int j = 0; j < 4; ++j) { v[j] = v[j] * rs * mul[j] + add[j]; o8[64 * j] = (unsigned long long)pk2(v[j].x, v[j].y) | ((unsigned long long)pk2(v[j].z, v[j].w) << 32); }
        float lg[36];
#pragma unroll
        for (int o = 0; o < 36; ++o) { float a = 0.f;
#pragma unroll
            for (int j = 0; j < 4; ++j) { const u32x2v w = *(const u32x2v*)(wrl + o * 512 + 2 * (F.lane + 64 * j)); a += v[j].x * bflo(w.x) + v[j].y * bfhi(w.x) + v[j].z * bflo(w.y) + v[j].w * bfhi(w.y); }
            lg[o] = wave_sum(a); }
        float gl[4]; int gi = 0;
#pragma unroll
        for (int i = 0; i < 4; ++i) gl[i] = lg[i] + bgp[i];
        float gmax = gl[0];
#pragma unroll
        for (int i = 1; i < 4; ++i) if (gl[i] > gmax) { gmax = gl[i]; gi = i; }
        float gsum = 0.f;
#pragma unroll
        for (int i = 0; i < 4; ++i) gsum += __expf(gl[i] - gmax);
        const float gp = 1.0f / gsum;
        float el[8];
#pragma unroll
        for (int i = 0; i < 8; ++i) { float x0 = lg[4 + i] + bep[i], x1 = lg[12 + i] + bep[8 + i], x2 = lg[20 + i] + bep[16 + i], x3 = lg[28 + i] + bep[24 + i]; el[i] = gi == 0 ? x0 : gi == 1 ? x1 : gi == 2 ? x2 : x3; }
        int e1 = 0; float l1 = el[0];
#pragma unroll
        for (int i = 1; i < 8; ++i) if (el[i] > l1) { l1 = el[i]; e1 = i; }
        int e2 = -1; float l2 = -INFINITY;
#pragma unroll
        for (int i = 0; i < 8; ++i) if (i != e1 && el[i] > l2) { l2 = el[i]; e2 = i; }
        const float t2 = __expf(l2 - l1); const float w1 = gp / (1.0f + t2), w2 = gp * t2 / (1.0f + t2);
        if (F.lane == 0) { EXPERT[2 * m] = gi * 8 + e1; EXPERT[2 * m + 1] = gi * 8 + e2; GATE[2 * m] = w1; GATE[2 * m + 1] = w2; atomicAdd(&hist[gi * 8 + e1], 1); atomicAdd(&hist[gi * 8 + e2], 1); }
    }
    __syncthreads();
    if (F.tid < 32) ((int*)(ws + WS_ROUTE + RT_CNT))[F.bid * 32 + F.tid] = hist[F.tid];
    __syncthreads();
}

__device__ __forceinline__ void slot_gather(Frame& F) {
    unsigned char* ws = F.ws;
    int* L = (int*)F.lds; int* partAll = L, *partBef = L + 512, *tot = L + 1024, *bef = L + 1056, *base = L + 1088, *cursor = L + 1120, *slotL = L + 1152;
    const int* CNT = (const int*)(ws + WS_ROUTE + RT_CNT);
    { const int e = F.tid & 31, part = F.tid >> 5; int sa = 0, sb = 0;
      for (int w = part * 16; w < part * 16 + 16; ++w) { const int c = CNT[w * 32 + e]; sa += c; if (w < F.bid) sb += c; }
      partAll[part * 32 + e] = sa; partBef[part * 32 + e] = sb; }
    __syncthreads();
    if (F.tid < 32) { int sa = 0, sb = 0; for (int p = 0; p < 16; ++p) { sa += partAll[p * 32 + F.tid]; sb += partBef[p * 32 + F.tid]; } tot[F.tid] = sa; bef[F.tid] = sb; cursor[F.tid] = 0; }
    __syncthreads();
    if (F.tid == 0) { int ps = 0; int* TILE = (int*)(ws + WS_ROUTE + RT_TILE); int ti = 0;
        for (int e = 0; e < 32; ++e) { base[e] = ps + bef[e]; const int nt = (tot[e] + 255) >> 8; if (F.bid == 0) for (int t = 0; t < nt; ++t) TILE[1 + ti + t] = e; ti += nt; ps += nt * 256; }
        if (F.bid == 0) TILE[0] = ti; }
    __syncthreads();
    const int* EXPERT = (const int*)(ws + WS_ROUTE + RT_EXPERT); const float* GATE = (const float*)(ws + WS_ROUTE + RT_GATE);
    int* TOKSLOT = (int*)(ws + WS_ROUTE + RT_TOKSLOT); float* SLOTW = (float*)(ws + WS_ROUTE + RT_SLOTW);
    { const int a = F.tid; const size_t idx = (size_t)F.bid * 512 + a; const int e = EXPERT[idx]; const int rank = atomicAdd(&cursor[e], 1); const int slot = base[e] + rank;
      SLOTW[slot] = GATE[idx]; TOKSLOT[idx] = slot; slotL[a] = slot; }
    __syncthreads();
    const bf16* XN = (const bf16*)(ws + WS_XN); bf16* XS = (bf16*)(ws + WS_XS);
    for (int i = 0; i < 64; ++i) { const int a = F.wave * 64 + i; const int slot = slotL[a]; const size_t tok = (size_t)F.bid * 256 + (a >> 1);
        const v4u* src = (const v4u*)(XN + tok * 1024); v4u* dst = (v4u*)(XS + (size_t)slot * 1024);
        dst[F.lane] = src[F.lane]; dst[64 + F.lane] = src[64 + F.lane]; }
    __syncthreads();
}

__device__ __forceinline__ void combine_rows(Frame& F, int l, bool next_norm) {
    unsigned char* ws = F.ws;
    const int gw = F.bid * NWAVES + F.wave; const int m0 = gw * 32, b = m0 >> 11;
    const float* MODl = (const float*)(ws + WS_MOD) + ((size_t)l * 32 + b) * 6144;
    f32x4 gt2[4], mul[4], add[4];
#pragma unroll
    for (int j = 0; j < 4; ++j) { const int e = 4 * (F.lane + 64 * j); gt2[j] = *(const f32x4*)(MODl + 5120 + e); mul[j] = gt2[j]; add[j] = gt2[j]; }
    if (next_norm) { const float* g = F.A->in[I_N1G] + (l + 1) * 1024; const float* MODn = (const float*)(ws + WS_MOD) + ((size_t)(l + 1) * 32 + b) * 6144;
#pragma unroll
        for (int j = 0; j < 4; ++j) { const int e = 4 * (F.lane + 64 * j); const f32x4 gv = *(const f32x4*)(g + e), sc = *(const f32x4*)(MODn + 1024 + e); mul[j] = gv * (1.0f + sc); add[j] = *(const f32x4*)(MODn + e); } }
    const int* TOKSLOT = (const int*)(ws + WS_ROUTE + RT_TOKSLOT); const bf16* YS = (const bf16*)(ws + WS_XS); bf16* XN = (bf16*)(ws + WS_XN);
    for (int r = 0; r < 32; ++r) {
        const size_t m = (size_t)(m0 + r);
        const int s0 = TOKSLOT[2 * m], s1 = TOKSLOT[2 * m + 1];
        f32x4* xr = (f32x4*)(F.out + m * 1024) + F.lane;
        const u32x2v* y0 = (const u32x2v*)(YS + (size_t)s0 * 1024) + F.lane; const u32x2v* y1 = (const u32x2v*)(YS + (size_t)s1 * 1024) + F.lane;
        f32x4 v[4]; float s = 0.f;
#pragma unroll
        for (int j = 0; j < 4; ++j) { const f32x4 x = xr[64 * j]; const u32x2v a = y0[64 * j], c = y1[64 * j];
            f32x4 y; y.x = bflo(a.x) + bflo(c.x); y.y = bfhi(a.x) + bfhi(c.x); y.z = bflo(a.y) + bflo(c.y); y.w = bfhi(a.y) + bfhi(c.y);
            v[j] = x + gt2[j] * y; xr[64 * j] = v[j]; s += (v[j].x * v[j].x + v[j].y * v[j].y) + (v[j].z * v[j].z + v[j].w * v[j].w); }
        if (next_norm) {
            const float rs = rsqrtf(wave_sum(s) * (1.0f / 1024.0f) + 1e-6f);
            unsigned long long* o8 = (unsigned long long*)(XN + m * 1024) + F.lane;
#pragma unroll
            for (int j = 0; j < 4; ++j) { const f32x4 h = v[j] * rs * mul[j] + add[j]; o8[64 * j] = (unsigned long long)pk2(h.x, h.y) | ((unsigned long long)pk2(h.z, h.w) << 32); }
        }
    }
}

__device__ __forceinline__ void dsa_prep(Frame& F, int l) {
    bf16* P = (bf16*)(F.ws + WS_P); const float* rope = (const float*)(F.ws + WS_ROPE);
    const float* gq = F.A->in[I_QNG] + l * 64; const float* gk = F.A->in[I_KNG] + l * 64;
    const int gw = F.bid * NWAVES + F.wave; const int hh = F.lane >> 4, i = F.lane & 15;
    const float gq0 = gq[i], gq1 = gq[i + 16], gq2 = gq[i + 32], gq3 = gq[i + 48];
    const float gk0 = gk[i], gk1 = gk[i + 16], gk2 = gk[i + 32], gk3 = gk[i + 48];
    for (int r = 0; r < 32; ++r) {
        const size_t m = (size_t)gw * 32 + r; const int pos = (int)(m & 2047);
        bf16* row = P + m * PW; const float* rp = rope + (size_t)pos * 64;
        const float c0 = rp[2 * i], s0 = rp[2 * i + 1], c1 = rp[2 * (i + 16)], s1 = rp[2 * (i + 16) + 1];
        { bf16* q = row + D_Q + hh * 64;
          const float x0 = bf2f(q[i]), x1 = bf2f(q[i + 16]), x2 = bf2f(q[i + 32]), x3 = bf2f(q[i + 48]);
          const float rs = rsqrtf(sum16(x0 * x0 + x1 * x1 + x2 * x2 + x3 * x3) * (1.0f / 64.0f) + 1e-6f);
          const float a0 = x0 * rs * gq0, a1 = x1 * rs * gq1, a2 = x2 * rs * gq2, a3 = x3 * rs * gq3;
          q[i] = (bf16)f2bf(a0 * c0 - a2 * s0); q[i + 32] = (bf16)f2bf(a2 * c0 + a0 * s0);
          q[i + 16] = (bf16)f2bf(a1 * c1 - a3 * s1); q[i + 48] = (bf16)f2bf(a3 * c1 + a1 * s1); }
        { bf16* k = row + D_K;
          const float x0 = bf2f(k[i]), x1 = bf2f(k[i + 16]), x2 = bf2f(k[i + 32]), x3 = bf2f(k[i + 48]);
          const float rs = rsqrtf(sum16(x0 * x0 + x1 * x1 + x2 * x2 + x3 * x3) * (1.0f / 64.0f) + 1e-6f);
          const float a0 = x0 * rs * gk0, a1 = x1 * rs * gk1, a2 = x2 * rs * gk2, a3 = x3 * rs * gk3;
          const unsigned short o0 = (bf16)f2bf(a0 * c0 - a2 * s0), o2 = (bf16)f2bf(a2 * c0 + a0 * s0), o1 = (bf16)f2bf(a1 * c1 - a3 * s1), o3 = (bf16)f2bf(a3 * c1 + a1 * s1);
          asm volatile("" ::: "memory");
          if (hh == 0) { k[i] = o0; k[i + 32] = o2; k[i + 16] = o1; k[i + 48] = o3; } }
        const float ci = rp[4 * i], si = rp[4 * i + 1];
        { bf16* qi = row + D_QI + hh * 32; const float x1 = bf2f(qi[i]), x2 = bf2f(qi[i + 16]); qi[i] = (bf16)f2bf(x1 * ci - x2 * si); qi[i + 16] = (bf16)f2bf(x2 * ci + x1 * si); }
        { bf16* ki = row + D_KI; const float x1 = bf2f(ki[i]), x2 = bf2f(ki[i + 16]); const unsigned short o1 = (bf16)f2bf(x1 * ci - x2 * si), o2 = (bf16)f2bf(x2 * ci + x1 * si);
          asm volatile("" ::: "memory");
          if (hh == 0) { ki[i] = o1; ki[i + 16] = o2; } }
        if (F.lane < 4) { bf16* wi = row + D_WI; wi[F.lane] = (bf16)f2bf(bf2f(wi[F.lane]) * 0.08838834764831845f); }
    }
}

__device__ __forceinline__ void rwkv_item(Frame& F, int l, int b, int h) {
    const bf16* P = (const bf16*)(F.ws + WS_P); bf16* YC = (bf16*)(F.ws + WS_YCAT);
    float* RAW = (float*)F.lds;
    float* W2H = RAW + 32 * 320;
    float* A2H = W2H + 32 * 64;
    float* G2H = A2H + 32 * 64;
    float* VEC = G2H + 64 * 64;
    float* YS = VEC + 32 * 7 * 64;
    float* BON = YS + 32 * 64;
    float* PAR = BON + 32;
    const int tid = F.tid;
    const float* mu = F.A->in[I_MU] + l * 896;
    for (int i = tid; i < 32 * 64; i += 512) { const int j = i >> 6, c = i & 63; W2H[i] = F.A->in[I_W2][((size_t)l * 32 + j) * 256 + h * 64 + c]; A2H[i] = F.A->in[I_A2][((size_t)l * 32 + j) * 256 + h * 64 + c]; }
    for (int i = tid; i < 64 * 64; i += 512) { const int j = i >> 6, c = i & 63; G2H[i] = F.A->in[I_G2][((size_t)l * 64 + j) * 256 + h * 64 + c]; }
    if (tid < 448) { const int w = tid >> 6, c = tid & 63; const float* sp = w == 0 ? F.A->in[I_W0] : w == 1 ? F.A->in[I_A0] : w == 2 ? F.A->in[I_KK] : w == 3 ? F.A->in[I_KA] : w == 4 ? F.A->in[I_RK] : w == 5 ? F.A->in[I_LNG] : F.A->in[I_LNB]; PAR[tid] = sp[l * 256 + h * 64 + c]; }
    float S[8];
#pragma unroll
    for (int j = 0; j < 8; ++j) S[j] = 0.f;
    const int row = tid >> 3, seg = tid & 7;
    const int pt = tid >> 4, cg = tid & 15;
    __syncthreads();
    for (int t0 = 0; t0 < SEQ; t0 += 32) {
        for (int i = 0; i < 20; ++i) { const int idx = tid + 512 * i; const int t = idx / 320, col = idx % 320;
            const int pc = col < 64 ? A_R + h * 64 + col : col < 128 ? A_K + h * 64 + (col - 64) : col < 192 ? A_V + h * 64 + (col - 128) : col < 224 ? A_WD + (col - 192) : col < 256 ? A_AD + (col - 224) : A_GD + (col - 256);
            const size_t m = (size_t)b * SEQ + t0 + t; const float cur = bf2f(P[m * PW + pc]); const float prev = (t0 + t > 0) ? bf2f(P[(m - 1) * PW + pc]) : 0.f;
            float v = cur + (prev - cur) * mu[pc];
            if (col >= 192 && col < 224) v = tanhf(v); else if (col >= 256) v = sigmoidf_(v);
            RAW[idx] = v; }
        __syncthreads();
        { const float* rw = RAW + pt * 320; f32x4 wv = *(const f32x4*)(PAR + 4 * cg), av = *(const f32x4*)(PAR + 64 + 4 * cg), gv = {0.f, 0.f, 0.f, 0.f};
#pragma unroll 8
          for (int j = 0; j < 32; ++j) { wv += rw[192 + j] * *(const f32x4*)(W2H + j * 64 + 4 * cg); av += rw[224 + j] * *(const f32x4*)(A2H + j * 64 + 4 * cg); }
#pragma unroll 8
          for (int j = 0; j < 64; ++j) gv += rw[256 + j] * *(const f32x4*)(G2H + j * 64 + 4 * cg);
          const f32x4 rr = *(const f32x4*)(rw + 4 * cg), kk0 = *(const f32x4*)(rw + 64 + 4 * cg), vv = *(const f32x4*)(rw + 128 + 4 * cg);
          const f32x4 k_k = *(const f32x4*)(PAR + 128 + 4 * cg), k_a = *(const f32x4*)(PAR + 192 + 4 * cg), r_k = *(const f32x4*)(PAR + 256 + 4 * cg);
          f32x4 dec, aa, kkr, kmod; float n2 = 0.f, bon = 0.f;
#pragma unroll
          for (int i = 0; i < 4; ++i) { const float w = -softplusf_(-wv[i]) - 0.5f; dec[i] = __expf(-__expf(w)); aa[i] = sigmoidf_(av[i]); kkr[i] = kk0[i] * k_k[i]; n2 += kkr[i] * kkr[i];
              kmod[i] = kk0[i] * (1.0f + (aa[i] - 1.0f) * k_a[i]); bon += rr[i] * kmod[i] * r_k[i]; }
          n2 = sum16(n2); bon = sum16(bon);
          const float inv = 1.0f / fmaxf(sqrtf(n2), 1e-12f);
          float* ve = VEC + pt * 448 + 4 * cg;
          const f32x4 kkn = kkr * inv;
          *(f32x4*)(ve) = dec; *(f32x4*)(ve + 64) = kkn; *(f32x4*)(ve + 128) = kkn * aa; *(f32x4*)(ve + 192) = kmod; *(f32x4*)(ve + 256) = rr; *(f32x4*)(ve + 320) = vv; *(f32x4*)(ve + 384) = gv;
          if (cg == 0) BON[pt] = bon; }
        __syncthreads();
        for (int t = 0; t < 32; ++t) {
            const float* ve = VEC + t * 448 + seg * 8;
            const f32x4 d0 = *(const f32x4*)(ve), d1 = *(const f32x4*)(ve + 4), q0 = *(const f32x4*)(ve + 64), q1 = *(const f32x4*)(ve + 68), b0 = *(const f32x4*)(ve + 128), b1 = *(const f32x4*)(ve + 132),
                        m0 = *(const f32x4*)(ve + 192), m1 = *(const f32x4*)(ve + 196), r0 = *(const f32x4*)(ve + 256), r1 = *(const f32x4*)(ve + 260);
            const float vv = VEC[t * 448 + 320 + row];
            float sa = (S[0] * q0[0] + S[1] * q0[1]) + (S[2] * q0[2] + S[3] * q0[3]) + (S[4] * q1[0] + S[5] * q1[1]) + (S[6] * q1[2] + S[7] * q1[3]);
            sa = -sum8(sa);
#pragma unroll
            for (int j = 0; j < 4; ++j) { S[j] = S[j] * d0[j] + sa * b0[j] + vv * m0[j]; S[4 + j] = S[4 + j] * d1[j] + sa * b1[j] + vv * m1[j]; }
            float y = (S[0] * r0[0] + S[1] * r0[1]) + (S[2] * r0[2] + S[3] * r0[3]) + (S[4] * r1[0] + S[5] * r1[1]) + (S[6] * r1[2] + S[7] * r1[3]);
            y = sum8(y);
            if (seg == 0) YS[t * 64 + row] = y;
        }
        __syncthreads();
        { const f32x4 y = *(const f32x4*)(YS + pt * 64 + 4 * cg); const float mean = sum16((y[0] + y[1]) + (y[2] + y[3])) * (1.0f / 64.0f); const f32x4 d = y - mean;
          const float var = sum16((d[0] * d[0] + d[1] * d[1]) + (d[2] * d[2] + d[3] * d[3])) * (1.0f / 64.0f); const float rs = rsqrtf(var + 64e-5f);
          const f32x4 lg = *(const f32x4*)(PAR + 320 + 4 * cg), lb = *(const f32x4*)(PAR + 384 + 4 * cg);
          const float* ve = VEC + pt * 448 + 4 * cg; const f32x4 vv = *(const f32x4*)(ve + 320), gg = *(const f32x4*)(ve + 384);
          const f32x4 o = (d * rs * lg + lb + BON[pt] * vv) * gg;
          u32x2v w; w.x = pk2(o[0], o[1]); w.y = pk2(o[2], o[3]);
          *(u32x2v*)(YC + ((size_t)b * SEQ + t0 + pt) * 1024 + h * 64 + 4 * cg) = w; }
        __syncthreads();
    }
}

__device__ __forceinline__ void mlstm_item(Frame& F, int l, int b, int h) {
    const bf16* P = (const bf16*)(F.ws + WS_P); bf16* YC = (bf16*)(F.ws + WS_YCAT);
    float* VEC = (float*)F.lds;
    float* HS = VEC + 32 * 256;
    float* GT = HS + 32 * 64;
    float* LIF = GT + 128;
    const int tid = F.tid;
    const float* cw = F.A->in[I_CONVW] + (size_t)l * 4 * 512; const float* cb = F.A->in[I_CONVB] + l * 512;
    const float igb = F.A->in[I_IGB][l * 4 + h], fgb = F.A->in[I_FGB][l * 4 + h];
    float C[8], n[8];
#pragma unroll
    for (int j = 0; j < 8; ++j) { C[j] = 0.f; n[j] = 0.f; }
    float mrun = 0.f;
    const int row = tid >> 3, seg = tid & 7, pt = tid >> 4, cg = tid & 15;
    for (int t0 = 0; t0 < SEQ; t0 += 32) {
        for (int i = 0; i < 8; ++i) { const int idx = tid + 512 * i; const int t = idx >> 7, col = idx & 127, which = col >> 6, c = col & 63;
            const int ch = which * 256 + h * 64 + c; const int pc = (which ? C_K : C_Q) + h * 64 + c; const size_t m = (size_t)b * SEQ + t0 + t;
            float acc = cb[ch];
#pragma unroll
            for (int j = 0; j < 4; ++j) { const int tt = t0 + t - 3 + j; if (tt >= 0) acc += cw[j * 512 + ch] * bf2f(P[(m - 3 + j) * PW + pc]); }
            float v = acc * sigmoidf_(acc); if (which) v *= 0.125f;
            VEC[t * 256 + which * 64 + c] = v;
            const float pv = bf2f(P[m * PW + (which ? C_O : C_V) + h * 64 + c]);
            VEC[t * 256 + 128 + which * 64 + c] = which ? sigmoidf_(pv) : pv; }
        if (tid < 32) { const size_t m = (size_t)b * SEQ + t0 + tid; const float ig = bf2f(P[m * PW + C_I + h]) + igb, fg = bf2f(P[m * PW + C_F + h]) + fgb;
            const float li = 15.0f * tanhf(ig * (1.0f / 15.0f)); const float fc = 15.0f * tanhf(fg * (1.0f / 15.0f)); LIF[2 * tid] = li; LIF[2 * tid + 1] = -softplusf_(-fc); }
        __syncthreads();
        if (tid == 0) { for (int t = 0; t < 32; ++t) { const float li = LIF[2 * t], lf = LIF[2 * t + 1]; const float mn = fmaxf(lf + mrun, li); GT[4 * t] = __expf(lf + mrun - mn); GT[4 * t + 1] = __expf(li - mn); GT[4 * t + 2] = __expf(-mn); mrun = mn; } }
        __syncthreads();
        for (int t = 0; t < 32; ++t) {
            const float* ve = VEC + t * 256 + seg * 8;
            const f32x4 q0 = *(const f32x4*)(ve), q1 = *(const f32x4*)(ve + 4), k0 = *(const f32x4*)(ve + 64), k1 = *(const f32x4*)(ve + 68);
            const float vv = VEC[t * 256 + 128 + row]; const float fs = GT[4 * t], is = GT[4 * t + 1], em = GT[4 * t + 2];
            const float iv = is * vv;
#pragma unroll
            for (int j = 0; j < 4; ++j) { C[j] = fs * C[j] + iv * k0[j]; C[4 + j] = fs * C[4 + j] + iv * k1[j]; n[j] = fs * n[j] + is * k0[j]; n[4 + j] = fs * n[4 + j] + is * k1[j]; }
            float num = (C[0] * q0[0] + C[1] * q0[1]) + (C[2] * q0[2] + C[3] * q0[3]) + (C[4] * q1[0] + C[5] * q1[1]) + (C[6] * q1[2] + C[7] * q1[3]);
            float den = (n[0] * q0[0] + n[1] * q0[1]) + (n[2] * q0[2] + n[3] * q0[3]) + (n[4] * q1[0] + n[5] * q1[1]) + (n[6] * q1[2] + n[7] * q1[3]);
            num = sum8(num); den = sum8(den);
            if (seg == 0) HS[t * 64 + row] = num / fmaxf(fabsf(den), em);
        }
        __syncthreads();
        { const f32x4 hv = *(const f32x4*)(HS + pt * 64 + 4 * cg); const float ms = sum16((hv[0] * hv[0] + hv[1] * hv[1]) + (hv[2] * hv[2] + hv[3] * hv[3])) * (1.0f / 64.0f); const float rs = rsqrtf(ms + 1e-6f);
          const f32x4 g = *(const f32x4*)(F.A->in[I_MLG] + l * 256 + h * 64 + 4 * cg); const f32x4 og = *(const f32x4*)(VEC + pt * 256 + 192 + 4 * cg);
          const f32x4 o = og * (hv * rs * g);
          u32x2v w; w.x = pk2(o[0], o[1]); w.y = pk2(o[2], o[3]);
          *(u32x2v*)(YC + ((size_t)b * SEQ + t0 + pt) * 1024 + 512 + h * 64 + 4 * cg) = w; }
        __syncthreads();
    }
}

__device__ __forceinline__ void sb_item(Frame& F, int l, int b, int h, int qg) {
    const bf16* P = (const bf16*)(F.ws + WS_P); bf16* YC = (bf16*)(F.ws + WS_YCAT);
    const int t0w = __builtin_amdgcn_readfirstlane(qg * 512 + F.wave * 64); const int t = t0w + F.lane;
    const size_t mrow = (size_t)b * SEQ + t;
    float q[64], o[64];
    { const v4u* qp = (const v4u*)(P + mrow * PW + B_Q + h * 64);
#pragma unroll
      for (int i = 0; i < 8; ++i) { const v4u w = qp[i]; q[8 * i] = bflo(w.x) * 0.125f; q[8 * i + 1] = bfhi(w.x) * 0.125f; q[8 * i + 2] = bflo(w.y) * 0.125f; q[8 * i + 3] = bfhi(w.y) * 0.125f;
          q[8 * i + 4] = bflo(w.z) * 0.125f; q[8 * i + 5] = bfhi(w.z) * 0.125f; q[8 * i + 6] = bflo(w.w) * 0.125f; q[8 * i + 7] = bfhi(w.w) * 0.125f; } }
#pragma unroll
    for (int d = 0; d < 64; ++d) o[d] = 0.f;
    float cs = 0.f;
    for (int s = t0w + 62; s >= 0; --s) {
        const bf16* kr = P + ((size_t)b * SEQ + s) * PW + B_K + h * 64; const bf16* vr = P + ((size_t)b * SEQ + s) * PW + B_V + h * 64;
        float z0 = 0.f, z1 = 0.f;
#pragma unroll
        for (int i = 0; i < 8; ++i) { const v4u w = ((const v4u*)kr)[i];
            z0 += q[8 * i] * bflo(w.x) + q[8 * i + 2] * bflo(w.y) + q[8 * i + 4] * bflo(w.z) + q[8 * i + 6] * bflo(w.w);
            z1 += q[8 * i + 1] * bfhi(w.x) + q[8 * i + 3] * bfhi(w.y) + q[8 * i + 5] * bfhi(w.z) + q[8 * i + 7] * bfhi(w.w); }
        const float z = z0 + z1; const bool valid = s < t;
        const float sp = softplusf_(z);
        const float a = valid ? __expf((z - sp) + cs) : 0.f;
#pragma unroll
        for (int i = 0; i < 8; ++i) { const v4u w = ((const v4u*)vr)[i];
            o[8 * i] += a * bflo(w.x); o[8 * i + 1] += a * bfhi(w.x); o[8 * i + 2] += a * bflo(w.y); o[8 * i + 3] += a * bfhi(w.y);
            o[8 * i + 4] += a * bflo(w.z); o[8 * i + 5] += a * bfhi(w.z); o[8 * i + 6] += a * bflo(w.w); o[8 * i + 7] += a * bfhi(w.w); }
        if (valid) cs -= sp;
        if (s < t0w && __all(cs < -120.0f)) break;
    }
    float ms = 0.f;
#pragma unroll
    for (int d = 0; d < 64; ++d) ms += o[d] * o[d];
    const float rs = rsqrtf(ms * (1.0f / 64.0f) + 1e-6f);
    const float* g = F.A->in[I_SBG] + l * 256 + h * 64;
    v4u* op = (v4u*)(YC + mrow * 1024 + 256 + h * 64);
#pragma unroll
    for (int i = 0; i < 8; ++i) { v4u w; w.x = pk2(o[8 * i] * rs * g[8 * i], o[8 * i + 1] * rs * g[8 * i + 1]); w.y = pk2(o[8 * i + 2] * rs * g[8 * i + 2], o[8 * i + 3] * rs * g[8 * i + 3]);
        w.z = pk2(o[8 * i + 4] * rs * g[8 * i + 4], o[8 * i + 5] * rs * g[8 * i + 5]); w.w = pk2(o[8 * i + 6] * rs * g[8 * i + 6], o[8 * i + 7] * rs * g[8 * i + 7]); op[i] = w; }
}

__device__ __forceinline__ unsigned sortable(float v) { const unsigned u = __float_as_uint(v); return u ^ ((u >> 31) ? 0xffffffffu : 0x80000000u); }
__device__ __forceinline__ int wave_isum(int v) {
#pragma unroll
    for (int o = 1; o < 64; o <<= 1) v += __shfl_xor(v, o);
    return v;
}
__device__ __forceinline__ unsigned wave_umax(unsigned v) {
#pragma unroll
    for (int o = 1; o < 64; o <<= 1) { const unsigned w = (unsigned)__shfl_xor((int)v, o); v = w > v ? w : v; }
    return v;
}
__device__ __forceinline__ unsigned wave_umin(unsigned v) {
#pragma unroll
    for (int o = 1; o < 64; o <<= 1) { const unsigned w = (unsigned)__shfl_xor((int)v, o); v = w < v ? w : v; }
    return v;
}
__device__ __forceinline__ unsigned pkbf(float lo, float hi) { typedef float f2 __attribute__((ext_vector_type(2))); typedef __bf16 b2 __attribute__((ext_vector_type(2))); f2 v = {lo, hi}; b2 b = __builtin_convertvector(v, b2); return __builtin_bit_cast(unsigned, b); }

constexpr int DSA_VT_STRIDE = 36;
__device__ __forceinline__ void dsa_item(Frame& F, int l, int b, int qblk) {
    const bf16* P = (const bf16*)(F.ws + WS_P); bf16* YC = (bf16*)(F.ws + WS_YCAT);
    float* SC = (float*)F.lds;
    unsigned* MASKL = (unsigned*)(F.lds + 65536);
    bf16* VT = (bf16*)(F.lds + 98304);
    const int lane = F.lane, wave = F.wave, hi = lane >> 5, r32 = lane & 31, tid = F.tid;
    const size_t brow = (size_t)b * SEQ;
    for (int rd = 0; rd < 16; ++rd) {
        const int tq0 = qblk * 128 + rd * 8; const int nkt = (tq0 + 8 + 31) >> 5;
        { const int hh = r32 >> 3, qq = r32 & 7;
          const bf16* ap = P + (brow + tq0 + qq) * PW + D_QI + hh * 32 + 8 * hi;
          const bf16x8 a0 = *(const bf16x8*)(ap), a1 = *(const bf16x8*)(ap + 16);
          float wv[4][4];
#pragma unroll
          for (int j = 0; j < 4; ++j) { const u32x2v w = *(const u32x2v*)(P + (brow + tq0 + j + 4 * hi) * PW + D_WI); wv[0][j] = bflo(w.x); wv[1][j] = bfhi(w.x); wv[2][j] = bflo(w.y); wv[3][j] = bfhi(w.y); }
          for (int kt = wave; kt < nkt; kt += 8) {
              const int key = kt * 32 + r32; const bf16* bp = P + (brow + key) * PW + D_KI + 8 * hi;
              const bf16x8 b0 = *(const bf16x8*)(bp), b1 = *(const bf16x8*)(bp + 16);
              f32x16 acc = {0.f, 0.f, 0.f, 0.f, 0.f, 0.f, 0.f, 0.f, 0.f, 0.f, 0.f, 0.f, 0.f, 0.f, 0.f, 0.f};
              acc = __builtin_amdgcn_mfma_f32_32x32x16_bf16(a0, b0, acc, 0, 0, 0);
              acc = __builtin_amdgcn_mfma_f32_32x32x16_bf16(a1, b1, acc, 0, 0, 0);
#pragma unroll
              for (int j = 0; j < 4; ++j) { float s = wv[0][j] * fmaxf(acc[j], 0.f); s = fmaf(wv[1][j], fmaxf(acc[4 + j], 0.f), s); s = fmaf(wv[2][j], fmaxf(acc[8 + j], 0.f), s); s = fmaf(wv[3][j], fmaxf(acc[12 + j], 0.f), s);
                  SC[(j + 4 * hi) * 2048 + key] = s; }
          } }
        __syncthreads();
        { const int t = tq0 + wave; const int ql = rd * 8 + wave; unsigned* mrow = MASKL + ql * 64;
          if (t < 256) { const unsigned w = (lane * 32 + 31 <= t) ? 0xffffffffu : (lane * 32 > t) ? 0u : (0xffffffffu >> (31 - (t - lane * 32))); mrow[lane] = w; }
          else {
              unsigned u[32]; unsigned mx = 0u, mn = 0xffffffffu;
#pragma unroll
              for (int i = 0; i < 32; ++i) { const int key = lane + 64 * i; const bool adm = key <= t; const unsigned s = sortable(SC[wave * 2048 + key]); u[i] = adm ? s : 0u; mx = (adm && s > mx) ? s : mx; mn = (adm && s < mn) ? s : mn; }
              unsigned lo = wave_umin(mn), hi_ = wave_umax(mx); unsigned thr = 0u; bool exact = false;
              for (;;) {
                  if (lo >= hi_) break;
                  const unsigned mid = lo + ((hi_ - lo + 1u) >> 1);
                  int c = 0;
#pragma unroll
                  for (int i = 0; i < 32; ++i) c += (u[i] >= mid) ? 1 : 0;
                  c = wave_isum(c);
                  if (c == 256) { thr = mid; exact = true; break; }
                  if (c > 256) lo = mid; else hi_ = mid - 1u;
              }
              unsigned mylo = 0u;
              if (exact) {
#pragma unroll
                  for (int i = 0; i < 32; ++i) { const unsigned long long sb = __ballot(u[i] >= thr); if (lane == 2 * i) mylo = (unsigned)sb; if (lane == 2 * i + 1) mylo = (unsigned)(sb >> 32); }
              } else {
                  const unsigned T = lo; int cgt = 0;
#pragma unroll
                  for (int i = 0; i < 32; ++i) cgt += (u[i] > T) ? 1 : 0;
                  cgt = wave_isum(cgt); const int need = 256 - cgt; int acce = 0;
#pragma unroll
                  for (int i = 0; i < 32; ++i) { const bool eq = (u[i] == T); const unsigned long long ball = __ballot(eq);
                      const int pre = __builtin_amdgcn_mbcnt_hi((unsigned)(ball >> 32), __builtin_amdgcn_mbcnt_lo((unsigned)ball, 0u));
                      const bool sel = (u[i] > T) || (eq && (acce + pre < need)); acce += __popcll(ball);
                      const unsigned long long sb = __ballot(sel);
                      if (lane == 2 * i) mylo = (unsigned)sb; if (lane == 2 * i + 1) mylo = (unsigned)(sb >> 32); }
              }
              mrow[lane] = mylo; } }
        __syncthreads();
    }
    float gqm = 0.f, gkm = 0.f;
    for (int d = 0; d < 64; ++d) { gqm = fmaxf(gqm, fabsf(F.A->in[I_QNG][l * 64 + d])); gkm = fmaxf(gkm, fabsf(F.A->in[I_KNG][l * 64 + d])); }
    const float c1 = 0.125f * 1.4426950408889634f, c2 = 8.0f * gqm * gkm * 1.4426950408889634f;
    const int hh = r32 & 3;
    bf16x8 qf[2][4];
#pragma unroll
    for (int ct = 0; ct < 2; ++ct) { const int t = qblk * 128 + wave * 16 + ct * 8 + (r32 >> 2); const bf16* qp = P + (brow + t) * PW + D_Q + hh * 64 + 8 * hi;
#pragma unroll
        for (int s = 0; s < 4; ++s) qf[ct][s] = *(const bf16x8*)(qp + 16 * s); }
    f32x16 O[2][2];
#pragma unroll
    for (int ct = 0; ct < 2; ++ct)
#pragma unroll
        for (int dt = 0; dt < 2; ++dt)
#pragma unroll
            for (int r = 0; r < 16; ++r) O[ct][dt][r] = 0.f;
    float lsum[2] = {0.f, 0.f};
    const int nkt_item = (qblk + 1) * 4; const int tmaxw = qblk * 128 + wave * 16 + 15;
    const int skey = tid >> 3, sch = tid & 7;
    v4u vst = {0u, 0u, 0u, 0u};
    if (tid < 256) vst = *(const v4u*)(P + (brow + skey) * PW + D_V + 8 * sch);
    { if (tid < 256) { bf16* d = VT + (8 * sch) * DSA_VT_STRIDE + skey;
        d[0] = (bf16)(vst.x & 0xffff); d[DSA_VT_STRIDE] = (bf16)(vst.x >> 16); d[2 * DSA_VT_STRIDE] = (bf16)(vst.y & 0xffff); d[3 * DSA_VT_STRIDE] = (bf16)(vst.y >> 16);
        d[4 * DSA_VT_STRIDE] = (bf16)(vst.z & 0xffff); d[5 * DSA_VT_STRIDE] = (bf16)(vst.z >> 16); d[6 * DSA_VT_STRIDE] = (bf16)(vst.w & 0xffff); d[7 * DSA_VT_STRIDE] = (bf16)(vst.w >> 16); } }
    __syncthreads();
    for (int kt = 0; kt < nkt_item; ++kt) {
        const int buf = kt & 1;
        if (tid < 256 && kt + 1 < nkt_item) vst = *(const v4u*)(P + (brow + (kt + 1) * 32 + skey) * PW + D_V + 8 * sch);
        if (kt * 32 <= tmaxw) {
            const bf16* kp = P + (brow + kt * 32 + r32) * PW + D_K + 8 * hi;
            bf16x8 kf[4];
#pragma unroll
            for (int s = 0; s < 4; ++s) kf[s] = *(const bf16x8*)(kp + 16 * s);
            bf16x8 pb[2][2];
#pragma unroll
            for (int ct = 0; ct < 2; ++ct) {
                f32x16 S = {0.f, 0.f, 0.f, 0.f, 0.f, 0.f, 0.f, 0.f, 0.f, 0.f, 0.f, 0.f, 0.f, 0.f, 0.f, 0.f};
#pragma unroll
                for (int s = 0; s < 4; ++s) S = __builtin_amdgcn_mfma_f32_32x32x16_bf16(kf[s], qf[ct][s], S, 0, 0, 0);
                const unsigned word = MASKL[(wave * 16 + ct * 8 + (r32 >> 2)) * 64 + kt]; const unsigned wsh = word >> (4 * hi);
                float pr[16];
#pragma unroll
                for (int r = 0; r < 16; ++r) { const bool bit = (wsh >> ((r & 3) + 8 * (r >> 2))) & 1u; const float p = bit ? __builtin_amdgcn_exp2f(fmaf(S[r], c1, -c2)) : 0.f; pr[r] = p; lsum[ct] += p; }
                v4u w0, w1;
                w0.x = pkbf(pr[0], pr[1]); w0.y = pkbf(pr[2], pr[3]); w0.z = pkbf(pr[4], pr[5]); w0.w = pkbf(pr[6], pr[7]);
                w1.x = pkbf(pr[8], pr[9]); w1.y = pkbf(pr[10], pr[11]); w1.z = pkbf(pr[12], pr[13]); w1.w = pkbf(pr[14], pr[15]);
                pb[ct][0] = __builtin_bit_cast(bf16x8, w0); pb[ct][1] = __builtin_bit_cast(bf16x8, w1);
            }
            const bf16* vb = VT + buf * (64 * DSA_VT_STRIDE);
#pragma unroll
            for (int dt = 0; dt < 2; ++dt)
#pragma unroll
                for (int s2 = 0; s2 < 2; ++s2) {
                    const bf16* vp = vb + (32 * dt + r32) * DSA_VT_STRIDE + 16 * s2 + 4 * hi;
                    const u32x2v v0 = *(const u32x2v*)(vp), v1 = *(const u32x2v*)(vp + 8);
                    v4u vw; vw.x = v0.x; vw.y = v0.y; vw.z = v1.x; vw.w = v1.y;
                    const bf16x8 vf = __builtin_bit_cast(bf16x8, vw);
#pragma unroll
                    for (int ct = 0; ct < 2; ++ct) O[ct][dt] = __builtin_amdgcn_mfma_f32_32x32x16_bf16(vf, pb[ct][s2], O[ct][dt], 0, 0, 0);
                }
        }
        if (tid < 256 && kt + 1 < nkt_item) { bf16* d = VT + (buf ^ 1) * (64 * DSA_VT_STRIDE) + (8 * sch) * DSA_VT_STRIDE + skey;
            d[0] = (bf16)(vst.x & 0xffff); d[DSA_VT_STRIDE] = (bf16)(vst.x >> 16); d[2 * DSA_VT_STRIDE] = (bf16)(vst.y & 0xffff); d[3 * DSA_VT_STRIDE] = (bf16)(vst.y >> 16);
            d[4 * DSA_VT_STRIDE] = (bf16)(vst.z & 0xffff); d[5 * DSA_VT_STRIDE] = (bf16)(vst.z >> 16); d[6 * DSA_VT_STRIDE] = (bf16)(vst.w & 0xffff); d[7 * DSA_VT_STRIDE] = (bf16)(vst.w >> 16); }
        __syncthreads();
    }
    const float* g = F.A->in[I_DOG] + l * 256 + hh * 64;
#pragma unroll
    for (int ct = 0; ct < 2; ++ct) {
        const float ls = lsum[ct] + __shfl_xor(lsum[ct], 32); const float il = 1.0f / ls;
        float ms = 0.f;
#pragma unroll
        for (int dt = 0; dt < 2; ++dt)
#pragma unroll
            for (int r = 0; r < 16; ++r) { const float o = O[ct][dt][r] * il; O[ct][dt][r] = o; ms += o * o; }
        ms += __shfl_xor(ms, 32);
        const float rs = rsqrtf(ms * (1.0f / 64.0f) + 1e-6f);
        const int t = qblk * 128 + wave * 16 + ct * 8 + (r32 >> 2);
        bf16* op = YC + (brow + t) * 1024 + 768 + hh * 64;
#pragma unroll
        for (int dt = 0; dt < 2; ++dt)
#pragma unroll
            for (int g4 = 0; g4 < 4; ++g4) { const int d0 = 32 * dt + 8 * g4 + 4 * hi; const f32x4 gv = *(const f32x4*)(g + d0);
                u32x2v w; w.x = pk2(O[ct][dt][4 * g4] * rs * gv[0], O[ct][dt][4 * g4 + 1] * rs * gv[1]); w.y = pk2(O[ct][dt][4 * g4 + 2] * rs * gv[2], O[ct][dt][4 * g4 + 3] * rs * gv[3]);
                *(u32x2v*)(op + d0) = w; }
    }
    __syncthreads();
}
#define REFRESH() do { int t_ = threadIdx.x; asm volatile("" : "+v"(t_)); F.tid = t_; F.lane = t_ & 63; F.wave = __builtin_amdgcn_readfirstlane(t_ >> 6); } while (0)
__device__ __forceinline__ void mixers_phase(Frame& F, int l) {
    volatile int* qslot = (volatile int*)(F.lds + MISC_OFF + 64);
    for (;;) {
        __syncthreads();
        if (F.tid == 0) *qslot = (int)__hip_atomic_fetch_add((unsigned*)(F.ctl + CW_Q + 64 * l), 1u, __ATOMIC_RELAXED, __HIP_MEMORY_SCOPE_AGENT);
        __syncthreads();
        const int it = __builtin_amdgcn_readfirstlane(*qslot);
        if (it >= 1280) break;
        if (it < 128) { if (PHE(11)) { for (int rp_ = 0; rp_ < REPN(11); ++rp_) { REFRESH(); rwkv_item(F, l, it >> 2, it & 3); } } }
        else if (it < 256) { if (PHE(12)) { for (int rp_ = 0; rp_ < REPN(12); ++rp_) { REFRESH(); mlstm_item(F, l, (it - 128) >> 2, (it - 128) & 3); } } }
        else if (it < 768) { const int j = it - 256; if (PHE(13)) { for (int rp_ = 0; rp_ < REPN(13); ++rp_) { REFRESH(); dsa_item(F, l, j & 31, 15 - (j >> 5)); } } }
        else { const int j = it - 768; if (PHE(14)) { for (int rp_ = 0; rp_ < REPN(14); ++rp_) { REFRESH(); sb_item(F, l, j >> 4, (j >> 2) & 3, j & 3); } } }
    }
}

constexpr int PH_PER_LAYER = 10, N_PHASES = 1 + PH_PER_LAYER * DEPTH;
__global__ void __launch_bounds__(NWAVES * 64, 2) mk_fwd(Args args) {
    extern __shared__ __attribute__((aligned(16))) unsigned char lds[];
    Frame F;
    F.lds = lds;
    F.tid = threadIdx.x; F.lane = F.tid & 63; F.wave = __builtin_amdgcn_readfirstlane(F.tid >> 6);
    F.G = gridDim.x; F.bid = blockIdx.x; { const int bx = blockIdx.x; F.vcu = (F.G % 8 == 0) ? (bx % 8) * (F.G / 8) + bx / 8 : bx; }
    F.ws = args.ws; F.out = args.out; F.ctl = (gu32*)(args.ws + WS_CTL);
    F.A = &args;
    volatile LAS unsigned* MISC = (volatile LAS unsigned*)((LAS unsigned char*)lds + MISC_OFF);
    for (int u = F.tid; u < (LDS_BYTES - MISC_OFF) / 4; u += NWAVES * 64) MISC[u] = 0u;
    __syncthreads();
    const int lo = args.ph_lo, hi = args.ph_hi;
    const bool multi = (hi - lo) > 1;
    XcdBarrier bar; bar.bar = (unsigned*)(F.ctl + CW_BAR); bar.x = 0; bar.st = nullptr;
    if (multi) bar = xcd_barrier_post((unsigned*)(F.ctl + CW_BAR), MISC + 8);
#define IN(k) (lo <= (k) && (k) < hi)
#define PB() do { int t_ = threadIdx.x; asm volatile("" : "+v"(t_)); F.tid = t_; F.lane = t_ & 63; F.wave = __builtin_amdgcn_readfirstlane(t_ >> 6); int b_ = blockIdx.x; asm volatile("" : "+s"(b_)); F.bid = b_; } while (0)
#define SEAM(k) do { if (IN(k) && IN((k) + 1)) xcd_barrier(bar); } while (0)
    LAS unsigned char* ldsl = (LAS unsigned char*)lds;
    bf16* XN = (bf16*)(F.ws + WS_XN); bf16* Pb = (bf16*)(F.ws + WS_P); bf16* YC = (bf16*)(F.ws + WS_YCAT);

    if (PHE(0) && IN(0)) { PB(); for (int rp_ = 0; rp_ < REPN(0); ++rp_) p0_prologue(F); }
    SEAM(0);
    for (int l = 0; l < DEPTH; ++l) {
        const int pb = 1 + PH_PER_LAYER * l;
        if (PHE(1) && IN(pb + 0)) { PB(); if (l == 0) for (int rp_ = 0; rp_ < REPN(1); ++rp_) norm_rows(F, F.A->in[I_X], 0, 0); }
        if (l == 0) SEAM(pb + 0);
        if (PHE(2) && IN(pb + 1)) { PB();
            pg8::Gemm g{1024}; pg8::DenseOrder S; S.init(XN, (const bf16*)(F.ws + WS_WIN) + (size_t)l * PW * 1024, NTOK, PW, 1024, F.G, F.bid);
            pg8::EpiBf16 E{Pb, PW};
            pg8::gemm_phase<pg8::EpiBf16, pg8::DenseOrder, true, true>(ldsl, g, S, E, F.tid);
            if (REPN(2) > 1) { PB(); pg8::gemm_phase<pg8::EpiBf16, pg8::DenseOrder, true, true>(ldsl, g, S, E, F.tid); }
        }
        SEAM(pb + 1);
        if (PHE(3) && IN(pb + 2)) { PB(); dsa_prep(F, l); }
        SEAM(pb + 2);
        if (PHE(4) && IN(pb + 3)) { PB(); mixers_phase(F, l); }
        SEAM(pb + 3);
        if (PHE(5) && IN(pb + 4)) { PB();
            pg8::Gemm g{1024}; pg8::DenseOrder S; S.init(YC, (const bf16*)(F.ws + WS_WOUT) + (size_t)l * 1024 * 1024, NTOK, 1024, 1024, F.G, F.bid);
            pg8::EpiRes E{l == 0 ? F.A->in[I_X] : (const float*)F.out, F.out, (const float*)(F.ws + WS_MOD) + (size_t)l * 32 * 6144 + 2048};
            pg8::gemm_phase<pg8::EpiRes, pg8::DenseOrder, true, true>(ldsl, g, S, E, F.tid);
            if (REPN(5) > 1 && l == 0) { PB(); pg8::gemm_phase<pg8::EpiRes, pg8::DenseOrder, true, true>(ldsl, g, S, E, F.tid); }
        }
        SEAM(pb + 4);
        if (PHE(6) && IN(pb + 5)) { PB(); for (int rp_ = 0; rp_ < REPN(6); ++rp_) norm2_route(F, l); }
        SEAM(pb + 5);
        if (PHE(7) && IN(pb + 6)) { PB(); for (int rp_ = 0; rp_ < REPN(7); ++rp_) slot_gather(F); }
        SEAM(pb + 6);
        if (PHE(8) && IN(pb + 7)) { PB();
            const int* TILE = (const int*)(F.ws + WS_ROUTE + RT_TILE); const int ntiles = TILE[0];
            pg8::Gemm g{1024}; pg8::MoeOrder S; S.ntiles = ntiles; S.nN = 4; S.nwg = ntiles * 4; S.G = F.G; S.c = F.bid; S.tile_e = TILE + 1;
            S.A = (const char*)(F.ws + WS_XS); S.W = (const char*)(F.ws + WS_W13) + (size_t)l * 32 * 1024 * 1024 * 2; S.a_tile = (size_t)256 * 1024 * 2; S.w_exp = (size_t)1024 * 1024 * 2; S.w_tile = (size_t)256 * 1024 * 2;
            pg8::EpiSwiGLU E{(bf16*)(F.ws + WS_H)};
            for (int rp_ = 0; rp_ < REPN(8); ++rp_) pg8::gemm_phase<pg8::EpiSwiGLU, pg8::MoeOrder, true, true>(ldsl, g, S, E, F.tid);
        }
        SEAM(pb + 7);
        if (PHE(9) && IN(pb + 8)) { PB();
            const int* TILE = (const int*)(F.ws + WS_ROUTE + RT_TILE); const int ntiles = TILE[0];
            pg8::Gemm g{512}; pg8::MoeOrder S; S.ntiles = ntiles; S.nN = 4; S.nwg = ntiles * 4; S.G = F.G; S.c = F.bid; S.tile_e = TILE + 1;
            S.A = (const char*)(F.ws + WS_H); S.W = (const char*)(F.ws + WS_W2) + (size_t)l * 32 * 1024 * 512 * 2; S.a_tile = (size_t)256 * 512 * 2; S.w_exp = (size_t)1024 * 512 * 2; S.w_tile = (size_t)256 * 512 * 2;
            pg8::EpiGate E{(bf16*)(F.ws + WS_XS), (const float*)(F.ws + WS_ROUTE + RT_SLOTW)};
            for (int rp_ = 0; rp_ < REPN(9); ++rp_) pg8::gemm_phase<pg8::EpiGate, pg8::MoeOrder, true, true>(ldsl, g, S, E, F.tid);
        }
        SEAM(pb + 8);
        if (PHE(10) && IN(pb + 9)) { PB(); combine_rows(F, l, l + 1 < DEPTH); }
        SEAM(pb + 9);
    }
#undef IN
#undef SEAM
}

extern "C" void kernel_launch(void* const* d_in, const int* in_sizes, int n_in, void* d_out, int out_size, void* d_ws, size_t ws_size, hipStream_t stream) {
    static int grid = 0;
    if (grid == 0) {
        if (n_in != 35 || out_size != NTOK * DM || ws_size < WS_END) { fprintf(stderr, "kernel_launch: unexpected shapes (n_in %d out %d ws %zu)\n", n_in, out_size, ws_size); grid = -1; return; }
        int dev = 0, cus = 0;
        if (hipGetDevice(&dev) != hipSuccess || hipDeviceGetAttribute(&cus, hipDeviceAttributeMultiprocessorCount, dev) != hipSuccess) { grid = -1; return; }
        if (hipFuncSetAttribute((const void*)mk_fwd, hipFuncAttributeMaxDynamicSharedMemorySize, LDS_BYTES) != hipSuccess) { fprintf(stderr, "kernel_launch: hipFuncSetAttribute failed\n"); grid = -1; return; }
        (void)hipGetLastError();
        grid = cus;
        if (grid != 256) { fprintf(stderr, "kernel_launch: built for 256 CUs, got %d\n", grid); grid = 256; }
    }
    if (grid < 0) return;
    (void)hipMemsetAsync((char*)d_ws + WS_CTL, 0, CTL_ZERO_BYTES, stream);
    Args a{};
    for (int i = 0; i < 35; ++i) a.in[i] = (const float*)d_in[i];
    a.out = (float*)d_out; a.ws = (unsigned char*)d_ws;
#if MK_ONE_LAUNCH
    a.ph_lo = 0; a.ph_hi = N_PHASES;
    hipLaunchKernelGGL(mk_fwd, dim3(grid), dim3(NWAVES * 64), LDS_BYTES, stream, a);
#else
    for (int p = 0; p < N_PHASES; ++p) { if (p == 1 + PH_PER_LAYER) continue; a.ph_lo = p; a.ph_hi = p + 1; hipLaunchKernelGGL(mk_fwd, dim3(grid), dim3(NWAVES * 64), LDS_BYTES, stream, a); }
#endif
}
```
